# Optimizing an MI355X kernel written in HIP

```python
import math
import jax, jax.numpy as jnp
from jax import lax
import numpy as np

D_MODEL = 1024
BATCH = 8
SEQ = 8192
DEPTH = 2

N_MEM = 256
D_MIX = D_MODEL
POOL_WIDTH = D_MIX // 4
POOL_WINDOWS = (2, 4, 8, 16)
POOL_GROUP = POOL_WIDTH // 4
CONV_WIDTH = D_MIX // 4
CONV_KSIZE = 31
NSA_WIDTH = D_MIX - POOL_WIDTH - CONV_WIDTH
HEAD_DIM = 64
N_HEADS = NSA_WIDTH // HEAD_DIM
N_KV = 2
Q_PER_KV = N_HEADS // N_KV
KV_WIDTH = N_KV * HEAD_DIM
CMP_LEN = 32
CMP_STRIDE = 16
CMP_HIDDEN = 256
SEL_BLOCK = 64
N_SELECT = 16
WINDOW = 512
Q_BLOCK = 128
N_BRANCH = 3
N_BUCKETS = 32
MAX_EXACT = 16
MAX_DISTANCE = 128
XA_HEADS = 4
XA_HEAD_DIM = D_MODEL // XA_HEADS
D_FF = 4 * D_MODEL
EPS = 1e-6
NEG_INF = -1e30
FORCE = 1e30
IN_SPLITS = (POOL_WIDTH, 2 * CONV_WIDTH, NSA_WIDTH, 6 * KV_WIDTH, N_HEADS * N_BRANCH)
D_IN = POOL_WIDTH + 2 * CONV_WIDTH + NSA_WIDTH + 6 * KV_WIDTH + N_HEADS * N_BRANCH

kernel_name = 'hybrid_pool_conformer_nsa_decoder'


def rms_norm(x, g):
    xf = x.astype(jnp.float32)
    y = xf * lax.rsqrt(jnp.mean(xf * xf, axis=-1, keepdims=True) + EPS)
    return (y * g.astype(jnp.float32)).astype(x.dtype)


def layer_norm(x, g, b):
    xf = x.astype(jnp.float32)
    mu = jnp.mean(xf, axis=-1, keepdims=True)
    var = jnp.mean(jnp.square(xf - mu), axis=-1, keepdims=True)
    y = (xf - mu) * lax.rsqrt(var + EPS) * g.astype(jnp.float32) + b.astype(jnp.float32)
    return y.astype(x.dtype)


def masked_softmax(logits, mask):
    p = jax.nn.softmax(jnp.where(mask, logits, NEG_INF), axis=-1)
    return jnp.where(mask, p, 0.0)


def rel_bucket(dist):
    n = jnp.maximum(dist, 0)
    nf = jnp.maximum(n, 1).astype(jnp.float32)
    large = MAX_EXACT + (jnp.log(nf / MAX_EXACT) / math.log(MAX_DISTANCE / MAX_EXACT)
                         * (N_BUCKETS - MAX_EXACT)).astype(jnp.int32)
    return jnp.where(n < MAX_EXACT, n, jnp.minimum(large, N_BUCKETS - 1))


def pool_mixer(u, w, scale):
    S = u.shape[1]
    uf = u.astype(jnp.float32)
    csum = jnp.cumsum(uf, axis=1)
    t1 = jnp.arange(1, S + 1, dtype=jnp.float32)
    outs = []
    for g, win in enumerate(POOL_WINDOWS):
        sl = slice(g * POOL_GROUP, (g + 1) * POOL_GROUP)
        cg = csum[..., sl]
        prev = jnp.pad(cg, ((0, 0), (win, 0), (0, 0)))[:, :S]
        mean = (cg - prev) / jnp.minimum(t1, win)[None, :, None]
        outs.append((mean - uf[..., sl]).astype(u.dtype) @ w[g])
    return jnp.concatenate(outs, axis=-1) * scale


def conv_mixer(u, conv_w, conv_b, ln_g, ln_b, pw):
    a, gate = jnp.split(u, 2, axis=-1)
    h = a * jax.nn.sigmoid(gate)
    h = lax.conv_general_dilated(
        h, conv_w[:, None, :], window_strides=(1,), padding=[(CONV_KSIZE - 1, 0)],
        dimension_numbers=('NWC', 'WIO', 'NWC'), feature_group_count=CONV_WIDTH) + conv_b
    h = jax.nn.silu(layer_norm(h, ln_g, ln_b))
    return h @ pw


def compress(kv, pos, w1, w2):
    B, S = kv.shape[0], kv.shape[1]
    nc = (S - CMP_LEN) // CMP_STRIDE + 1
    idx = jnp.arange(nc)[:, None] * CMP_STRIDE + jnp.arange(CMP_LEN)[None, :]
    blocks = kv[:, idx] + pos[None, None, :, None, :]
    flat = blocks.transpose(0, 1, 3, 2, 4).reshape(B, nc, N_KV, CMP_LEN * HEAD_DIM)
    return jax.nn.gelu(flat @ w1) @ w2


def nsa_mixer(q, k_c, v_c, k_s, v_s, k_w, v_w, gates, rel_bias,
              ck_pos, ck_w1, ck_w2, cv_pos, cv_w1, cv_w2):
    B, S = q.shape[0], q.shape[1]
    q = q.reshape(B, S, N_KV, Q_PER_KV, HEAD_DIM) * HEAD_DIM ** -0.5
    gates = gates.reshape(B, S, N_KV, Q_PER_KV, N_BRANCH)
    kc = compress(k_c, ck_pos, ck_w1, ck_w2)
    vc = compress(v_c, cv_pos, cv_w1, cv_w2)
    nc = kc.shape[1]
    n_sel = S // SEL_BLOCK
    top = min(N_SELECT, n_sel)
    ks_blocks = k_s.reshape(B, n_sel, SEL_BLOCK, N_KV, HEAD_DIM).transpose(0, 3, 1, 2, 4)
    vs_blocks = v_s.reshape(B, n_sel, SEL_BLOCK, N_KV, HEAD_DIM).transpose(0, 3, 1, 2, 4)
    kw_pad = jnp.pad(k_w, ((0, 0), (WINDOW, 0), (0, 0), (0, 0)))
    vw_pad = jnp.pad(v_w, ((0, 0), (WINDOW, 0), (0, 0), (0, 0)))
    c_start = jnp.arange(nc) * CMP_STRIDE
    c_end = c_start + CMP_LEN - 1
    s_idx = jnp.arange(n_sel)
    s_start = s_idx * SEL_BLOCK
    overlap = ((c_start[:, None] < s_start[None, :] + SEL_BLOCK)
               & (c_start[:, None] + CMP_LEN > s_start[None, :])).astype(jnp.float32)
    bias_tab = rel_bias.astype(jnp.float32).reshape(N_BUCKETS, N_KV, Q_PER_KV)
    b_ix = jnp.arange(B)[:, None, None, None]
    g_ix = jnp.arange(N_KV)[None, None, :, None]

    def block(i):
        s0 = i * Q_BLOCK
        t = s0 + jnp.arange(Q_BLOCK)
        qb = lax.dynamic_slice_in_dim(q, s0, Q_BLOCK, axis=1)
        gb = lax.dynamic_slice_in_dim(gates, s0, Q_BLOCK, axis=1)
        dist_c = t[:, None] - c_end[None, :]
        lc = (jnp.einsum('bqgrd,bcgd->bqgrc', qb, kc).astype(jnp.float32)
              + bias_tab[rel_bucket(dist_c)].transpose(0, 2, 3, 1)[None])
        pc = masked_softmax(lc, (dist_c >= 0)[:, None, None, :])
        oc = jnp.einsum('bqgrc,bcgd->bqgrd', pc.astype(vc.dtype), vc)
        imp = jnp.einsum('bqgrc,cj->bqgj', pc, overlap)
        cur = t // SEL_BLOCK
        forced = ((s_idx[None, :] == 0) | (s_idx[None, :] == cur[:, None])
                  | (s_idx[None, :] == cur[:, None] - 1))
        causal_s = s_start[None, :] <= t[:, None]
        score = jnp.where(forced[None, :, None, :], FORCE,
                          jnp.where(causal_s[None, :, None, :], imp, NEG_INF))
        _, idx = lax.top_k(score, top)
        ks_g = ks_blocks[b_ix, g_ix, idx].reshape(B, Q_BLOCK, N_KV, top * SEL_BLOCK, HEAD_DIM)
        vs_g = vs_blocks[b_ix, g_ix, idx].reshape(B, Q_BLOCK, N_KV, top * SEL_BLOCK, HEAD_DIM)
        pos_s = (idx[..., None] * SEL_BLOCK + jnp.arange(SEL_BLOCK)).reshape(
            B, Q_BLOCK, N_KV, top * SEL_BLOCK)
        dist_s = t[None, :, None, None] - pos_s
        bias_s = bias_tab[rel_bucket(dist_s), g_ix].transpose(0, 1, 2, 4, 3)
        ls = jnp.einsum('bqgrd,bqgld->bqgrl', qb, ks_g).astype(jnp.float32) + bias_s
        ps = masked_softmax(ls, (dist_s >= 0)[:, :, :, None, :])
        osl = jnp.einsum('bqgrl,bqgld->bqgrd', ps.astype(vs_g.dtype), vs_g)
        kwb = lax.dynamic_slice_in_dim(kw_pad, s0, WINDOW + Q_BLOCK, axis=1)
        vwb = lax.dynamic_slice_in_dim(vw_pad, s0, WINDOW + Q_BLOCK, axis=1)
        pos_w = s0 - WINDOW + jnp.arange(WINDOW + Q_BLOCK)
        dist_w = t[:, None] - pos_w[None, :]
        mask_w = (dist_w >= 0) & (dist_w < WINDOW) & (pos_w[None, :] >= 0)
        lw = (jnp.einsum('bqgrd,bkgd->bqgrk', qb, kwb).astype(jnp.float32)
              + bias_tab[rel_bucket(dist_w)].transpose(0, 2, 3, 1)[None])
        pw = masked_softmax(lw, mask_w[:, None, None, :])
        ow = jnp.einsum('bqgrk,bkgd->bqgrd', pw.astype(vwb.dtype), vwb)
        return gb[..., 0:1] * oc + gb[..., 1:2] * osl + gb[..., 2:3] * ow

    out = lax.map(block, jnp.arange(S // Q_BLOCK))
    return out.transpose(1, 0, 2, 3, 4, 5).reshape(B, S, NSA_WIDTH)


def setup_inputs(seed: int = 0) -> dict:
    key = jax.random.key(seed)
    ks = jax.random.split(key, 40)
    f32 = jnp.float32
    L = DEPTH

    def nrm(k, shape, fan_in):
        return jax.random.normal(k, shape, f32) * fan_in ** -0.5

    def gain(k, shape):
        return 1.0 + 0.05 * jax.random.normal(k, shape, f32)

    def small(k, shape):
        return 0.02 * jax.random.normal(k, shape, f32)

    return {
        'x': jax.random.normal(ks[0], (BATCH, SEQ, D_MODEL), f32),
        'mem': jax.random.normal(ks[1], (BATCH, N_MEM, D_MODEL), f32),
        'rel_bias': 0.5 * jax.random.normal(ks[2], (N_BUCKETS, N_HEADS), f32),
        'mix_pre_g': gain(ks[3], (L, D_MODEL)),
        'mix_post_g': gain(ks[4], (L, D_MODEL)),
        'w_in': nrm(ks[5], (L, D_MODEL, D_IN), D_MODEL),
        'pool_w': nrm(ks[6], (L, len(POOL_WINDOWS), POOL_GROUP, POOL_GROUP), POOL_GROUP),
        'pool_scale': gain(ks[7], (L, POOL_WIDTH)),
        'conv_w': nrm(ks[8], (L, CONV_KSIZE, CONV_WIDTH), CONV_KSIZE),
        'conv_b': small(ks[9], (L, CONV_WIDTH)),
        'conv_ln_g': gain(ks[10], (L, CONV_WIDTH)),
        'conv_ln_b': small(ks[11], (L, CONV_WIDTH)),
        'conv_pw': nrm(ks[12], (L, CONV_WIDTH, CONV_WIDTH), CONV_WIDTH),
        'cmp_k_pos': small(ks[13], (L, CMP_LEN, HEAD_DIM)),
        'cmp_k_w1': nrm(ks[14], (L, CMP_LEN * HEAD_DIM, CMP_HIDDEN), CMP_LEN * HEAD_DIM),
        'cmp_k_w2': nrm(ks[15], (L, CMP_HIDDEN, HEAD_DIM), CMP_HIDDEN),
        'cmp_v_pos': small(ks[16], (L, CMP_LEN, HEAD_DIM)),
        'cmp_v_w1': nrm(ks[17], (L, CMP_LEN * HEAD_DIM, CMP_HIDDEN), CMP_LEN * HEAD_DIM),
        'cmp_v_w2': nrm(ks[18], (L, CMP_HIDDEN, HEAD_DIM), CMP_HIDDEN),
        'w_out': nrm(ks[19], (L, D_MIX, D_MODEL), D_MIX),
        'xa_pre_g': gain(ks[20], (L, D_MODEL)),
        'xa_post_g': gain(ks[21], (L, D_MODEL)),
        'mem_g': gain(ks[22], (L, D_MODEL)),
        'xa_wq': nrm(ks[23], (L, D_MODEL, D_MODEL), D_MODEL),
        'xa_wk': nrm(ks[24], (L, D_MODEL, D_MODEL), D_MODEL),
        'xa_wv': nrm(ks[25], (L, D_MODEL, D_MODEL), D_MODEL),
        'xa_wo': nrm(ks[26], (L, D_MODEL, D_MODEL), D_MODEL),
        'mlp_pre_g': gain(ks[27], (L, D_MODEL)),
        'mlp_post_g': gain(ks[28], (L, D_MODEL)),
        'mlp_w1': nrm(ks[29], (L, D_MODEL, D_FF), D_MODEL),
        'mlp_w2': nrm(ks[30], (L, D_FF, D_MODEL), D_FF),
    }


def reference(x, mem, rel_bias, mix_pre_g, mix_post_g, w_in, pool_w, pool_scale,
              conv_w, conv_b, conv_ln_g, conv_ln_b, conv_pw,
              cmp_k_pos, cmp_k_w1, cmp_k_w2, cmp_v_pos, cmp_v_w1, cmp_v_w2, w_out,
              xa_pre_g, xa_post_g, mem_g, xa_wq, xa_wk, xa_wv, xa_wo,
              mlp_pre_g, mlp_post_g, mlp_w1, mlp_w2):
    B, S = x.shape[0], x.shape[1]
    M = mem.shape[1]
    offsets = [int(o) for o in np.cumsum(IN_SPLITS)[:-1]]
    for l in range(DEPTH):
        h = rms_norm(x, mix_pre_g[l])
        proj = h @ w_in[l]
        u_pool, u_conv, q, kv, gate_logits = jnp.split(proj, offsets, axis=-1)
        k_c, v_c, k_s, v_s, k_w, v_w = [a.reshape(B, S, N_KV, HEAD_DIM)
                                        for a in jnp.split(kv, 6, axis=-1)]
        y_pool = pool_mixer(u_pool, pool_w[l], pool_scale[l])
        y_conv = conv_mixer(u_conv, conv_w[l], conv_b[l], conv_ln_g[l],
                            conv_ln_b[l], conv_pw[l])
        y_nsa = nsa_mixer(q, k_c, v_c, k_s, v_s, k_w, v_w, jax.nn.sigmoid(gate_logits), rel_bias,
                          cmp_k_pos[l], cmp_k_w1[l], cmp_k_w2[l],
                          cmp_v_pos[l], cmp_v_w1[l], cmp_v_w2[l])
        mix = jnp.concatenate([y_pool, y_conv, y_nsa], axis=-1) @ w_out[l]
        x = x + rms_norm(mix, mix_post_g[l])
        h = rms_norm(x, xa_pre_g[l])
        m = rms_norm(mem, mem_g[l])
        qx = (h @ xa_wq[l]).reshape(B, S, XA_HEADS, XA_HEAD_DIM) * XA_HEAD_DIM ** -0.5
        km = (m @ xa_wk[l]).reshape(B, M, XA_HEADS, XA_HEAD_DIM)
        vm = (m @ xa_wv[l]).reshape(B, M, XA_HEADS, XA_HEAD_DIM)
        p = jax.nn.softmax(jnp.einsum('bshd,bmhd->bhsm', qx, km).astype(jnp.float32), axis=-1)
        o = jnp.einsum('bhsm,bmhd->bshd', p.astype(vm.dtype), vm).reshape(B, S, D_MODEL)
        x = x + rms_norm(o @ xa_wo[l], xa_post_g[l])
        h = rms_norm(x, mlp_pre_g[l])
        y = jnp.square(jax.nn.relu(h @ mlp_w1[l])) @ mlp_w2[l]
        x = x + rms_norm(y, mlp_post_g[l])
    return x
```

```cpp
#include <hip/hip_runtime.h>
#include <hip/hip_cooperative_groups.h>
#include <cstdio>
#include <cstdint>
#include <cmath>
namespace cg = cooperative_groups;

#define LAS __attribute__((address_space(3)))
typedef unsigned short bf16_t;
typedef short bf16x8 __attribute__((ext_vector_type(8)));
typedef short s16x4 __attribute__((ext_vector_type(4)));
typedef float f32x4 __attribute__((ext_vector_type(4)));
typedef float f32x2 __attribute__((ext_vector_type(2)));
typedef float f32x16 __attribute__((ext_vector_type(16)));
typedef unsigned u32x4 __attribute__((ext_vector_type(4)));
typedef unsigned u32x2 __attribute__((ext_vector_type(2)));

constexpr int NB = 8, SEQ = 8192, DM = 1024, MTOK = NB * SEQ, DINP = 2304, FF = 4096, NMEM = 256;
constexpr float LOG2E = 1.4426950408889634f;
constexpr float EPS = 1e-6f;
constexpr float NEGV = -1e30f;

constexpr size_t MiB = 1u << 20;
constexpr size_t WS_W = 1 * MiB, WS_WL = 40 * MiB;
constexpr size_t W_IN = 0, W_OUT = 5 * MiB, W_Q = 7 * MiB, W_O = 9 * MiB, W_1 = 11 * MiB, W_2 = 19 * MiB, W_K = 27 * MiB, W_V = 29 * MiB,
                 W_CK1 = 31 * MiB, W_CV1 = 32 * MiB, W_CK2 = 33 * MiB, W_CV2 = 33 * MiB + 128 * 1024, W_POOL = 33 * MiB + 256 * 1024,
                 W_CPW = 33 * MiB + 384 * 1024, W_CB1K = 33 * MiB + 512 * 1024, W_CB1V = 33 * MiB + 516 * 1024, W_MEMN = 34 * MiB;
constexpr size_t WS_KM = 82 * MiB, WS_VMT = 90 * MiB;
constexpr size_t WS_KCRAW = 100 * MiB, WS_VCRAW = 117 * MiB;
constexpr size_t WS_HIDK = 134 * MiB, WS_HIDV = 138 * MiB, WS_KC = 142 * MiB, WS_VC = 146 * MiB;
constexpr size_t WS_XN = 160 * MiB, WS_MIX = 288 * MiB, WS_BIG = 416 * MiB;
constexpr size_t WS_PROJ = WS_BIG, WS_CAT = 704 * MiB, WS_ACT = 832 * MiB, WS_HID = WS_BIG;
constexpr size_t WS_END = 928 * MiB;

constexpr int LDS_BYTES = 147456;
constexpr int XS_OFF = 131072;

__device__ __forceinline__ unsigned f2bf(float f) { unsigned u = __builtin_bit_cast(unsigned, f); return (u + 0x7fffu + ((u >> 16) & 1u)) >> 16; }
__device__ __forceinline__ unsigned pk2(float lo, float hi) { return f2bf(lo) | (f2bf(hi) << 16); }
__device__ __forceinline__ float bf2f(unsigned short b) { return __builtin_bit_cast(float, (unsigned)b << 16); }
__device__ __forceinline__ unsigned cvt_pk_bf16(float lo, float hi) { unsigned r; asm volatile("v_cvt_pk_bf16_f32 %0, %1, %2" : "=v"(r) : "v"(lo), "v"(hi)); return r; }
__device__ __forceinline__ float wave_sum(float v) {
#pragma unroll
    for (int o = 1; o < 64; o <<= 1) v += __shfl_xor(v, o);
    return v;
}
__device__ __forceinline__ float ex2(float x) { return __builtin_amdgcn_exp2f(x); }
__device__ __forceinline__ int opaque_tid() { int t = threadIdx.x; asm volatile("" : "+v"(t)); return t; }

namespace pg8 {
constexpr int BM = 256, BK = 64, HALF = 128, HTB = HALF * BK * 2, STAGE_BYTES = 8 * HTB, NXCD = 8, WGM = 8;
__host__ __device__ __forceinline__ int lds_byte(int r, int c) { const int st = (r >> 4) * 2 + (c >> 5), rr = r & 15, cc = c & 31, ob = rr * 64 + cc * 2; return st * 1024 + (ob ^ (((ob >> 9) & 1) << 5)); }
__host__ __device__ __forceinline__ void stage_rc(int b, int& R, int& C) { const int st = b / 1024, sb = b % 1024, swz = sb ^ (((sb >> 9) & 1) << 5); R = (st >> 1) * 16 + swz / 64; C = (st & 1) * 32 + (swz % 64) / 2; }
__host__ __device__ __forceinline__ int perm32(int rho) { const int n = rho >> 4, i = rho & 15; return 8 * (i >> 2) + 4 * n + (i & 3); }

struct Unit { int pm, pn; };
struct Gemm {
    const bf16_t* A; const bf16_t* Bt; int lda, ldb, K; size_t a_pn, b_pn, b_batch; int mtpb;
    __device__ __forceinline__ const char* a_ptr(const Unit& u) const { return (const char*)(A + (size_t)u.pm * BM * lda + (size_t)u.pn * a_pn); }
    __device__ __forceinline__ const char* b_ptr(const Unit& u) const { return (const char*)(Bt + (size_t)u.pn * b_pn + (size_t)(u.pm / mtpb) * b_batch); }
};
struct StaticOrder {
    int nM, nN, nwg, G, c;
    __device__ void init(int M, int N, int G_, int c_) { nM = M / BM; nN = N / BM; nwg = nM * nN; G = G_; c = c_; }
    __device__ bool next(int i, Unit& u) const {
        const long L = (long)i * G + c; if (L >= nwg) return false;
        int wgid = (int)L; { const int q = nwg / NXCD, r = nwg % NXCD, xcd = wgid % NXCD, off = wgid / NXCD; wgid = (xcd < r ? xcd * (q + 1) : r * (q + 1) + (xcd - r) * q) + off; }
        const int nig = WGM * nN, gid = wgid / nig, fm = gid * WGM, gsz = (nM - fm) < WGM ? (nM - fm) : WGM;
        u.pm = fm + ((wgid % nig) % gsz); u.pn = (wgid % nig) / gsz; return true;
    }
};

struct Epi {
    bf16_t* O; int ldc; const float* bias; int act; int sc_lo, sc_hi; float sc;
    __device__ __forceinline__ void operator()(f32x4 (&acc)[2][2][4][2], const Unit& u, int wr, int wc, int fr, int fq, LAS unsigned char* xs) const {
        const int row0 = u.pm * BM + wr * 64 + fr; const int col0 = u.pn * BM + wc * 32 + 8 * fq;
        const float s = (u.pn >= sc_lo && u.pn < sc_hi) ? sc : 1.f;
        if (act == 3) {
            LAS f32x2* XS = (LAS f32x2*)xs;
            float mloc[2][4];
#pragma unroll
            for (int ai = 0; ai < 2; ++ai)
#pragma unroll
                for (int m = 0; m < 4; ++m) {
                    float mx = NEGV;
#pragma unroll
                    for (int bj = 0; bj < 2; ++bj)
#pragma unroll
                        for (int n = 0; n < 2; ++n) { const f32x4 x = acc[ai][bj][m][n]; mx = fmaxf(mx, fmaxf(fmaxf(x[0], x[1]), fmaxf(x[2], x[3]))); }
                    mx = fmaxf(mx, __shfl_xor(mx, 16)); mx = fmaxf(mx, __shfl_xor(mx, 32));
                    float sm = 0.f;
#pragma unroll
                    for (int bj = 0; bj < 2; ++bj)
#pragma unroll
                        for (int n = 0; n < 2; ++n) { f32x4 x = acc[ai][bj][m][n]; x[0] = ex2(x[0] - mx); x[1] = ex2(x[1] - mx); x[2] = ex2(x[2] - mx); x[3] = ex2(x[3] - mx); acc[ai][bj][m][n] = x; sm += (x[0] + x[1]) + (x[2] + x[3]); }
                    sm += __shfl_xor(sm, 16); sm += __shfl_xor(sm, 32);
                    mloc[ai][m] = mx;
                    if (fq == 0) XS[(ai * HALF + wr * 64 + m * 16 + fr) * 4 + wc] = (f32x2){mx, sm};
                }
            asm volatile("s_waitcnt lgkmcnt(0)" ::: "memory"); __builtin_amdgcn_s_barrier(); asm volatile("" ::: "memory");
#pragma unroll
            for (int ai = 0; ai < 2; ++ai)
#pragma unroll
                for (int m = 0; m < 4; ++m) {
                    const int r = ai * HALF + wr * 64 + m * 16 + fr;
                    const f32x2 a = XS[r * 4 + 0], b = XS[r * 4 + 1], c = XS[r * 4 + 2], d = XS[r * 4 + 3];
                    const float mt = fmaxf(fmaxf(a.x, b.x), fmaxf(c.x, d.x));
                    const float l = a.y * ex2(a.x - mt) + b.y * ex2(b.x - mt) + c.y * ex2(c.x - mt) + d.y * ex2(d.x - mt);
                    const float f = ex2(mloc[ai][m] - mt) / l;
                    bf16_t* rowp = O + (size_t)(row0 + ai * HALF + m * 16) * ldc + col0;
#pragma unroll
                    for (int bj = 0; bj < 2; ++bj) { const f32x4 v0 = acc[ai][bj][m][0] * f, v1 = acc[ai][bj][m][1] * f;
                        u32x4 w; w.x = cvt_pk_bf16(v0[0], v0[1]); w.y = cvt_pk_bf16(v0[2], v0[3]); w.z = cvt_pk_bf16(v1[0], v1[1]); w.w = cvt_pk_bf16(v1[2], v1[3]);
                        *(u32x4*)(rowp + bj * HALF) = w; }
                }
            return;
        }
        f32x4 bv[2][2];
#pragma unroll
        for (int bj = 0; bj < 2; ++bj)
#pragma unroll
            for (int n = 0; n < 2; ++n) bv[bj][n] = bias ? *(const f32x4*)(bias + col0 + bj * HALF + 4 * n) : (f32x4){0.f, 0.f, 0.f, 0.f};
#pragma unroll
        for (int ai = 0; ai < 2; ++ai)
#pragma unroll
            for (int m = 0; m < 4; ++m) { bf16_t* rowp = O + (size_t)(row0 + ai * HALF + m * 16) * ldc + col0;
#pragma unroll
                for (int bj = 0; bj < 2; ++bj) { f32x4 v0 = acc[ai][bj][m][0] + bv[bj][0], v1 = acc[ai][bj][m][1] + bv[bj][1];
                    if (act == 1) {
#pragma unroll
                        for (int e = 0; e < 4; ++e) { float a = fmaxf(v0[e], 0.f), b = fmaxf(v1[e], 0.f); v0[e] = a * a; v1[e] = b * b; }
                    } else if (act == 2) {
#pragma unroll
                        for (int e = 0; e < 4; ++e) { float a = v0[e], b = v1[e];
                            float ua = 1.5957691216f * (a + 0.044715f * a * a * a), ub = 1.5957691216f * (b + 0.044715f * b * b * b);
                            v0[e] = a / (1.f + __expf(-ua)); v1[e] = b / (1.f + __expf(-ub)); }
                    }
                    v0 = v0 * s; v1 = v1 * s; u32x4 w; w.x = cvt_pk_bf16(v0[0], v0[1]); w.y = cvt_pk_bf16(v0[2], v0[3]); w.z = cvt_pk_bf16(v1[0], v1[1]); w.w = cvt_pk_bf16(v1[2], v1[3]);
                    *(u32x4*)(rowp + bj * HALF) = w; } }
    }
};

__device__ __forceinline__ void gemm_phase(LAS unsigned char* lds, const Gemm g, const StaticOrder& S, const Epi& E) {
    const int tid = opaque_tid(), wid = __builtin_amdgcn_readfirstlane(tid >> 6), lane = tid & 63, wr = wid >> 2, wc = wid & 3, fr = lane & 15, fq = lane >> 4;
    const int K = g.K, nt = K / BK;
    unsigned voffA[2], voffB[2];
#pragma unroll
    for (int i = 0; i < 2; ++i) { int R, C; stage_rc(tid * 16 + i * 8192, R, C); const int Rb = (R & ~31) + perm32(R & 31);
        voffA[i] = (unsigned)(R * g.lda + C) * 2u; voffB[i] = (unsigned)(Rb * g.ldb + C) * 2u; }
    const size_t kstep = (size_t)(BK * 2);
    const size_t hA = (size_t)HALF * g.lda * 2, hB = (size_t)HALF * g.ldb * 2;
    const unsigned ldsw = (unsigned)wid * 1024u;
    const int aoff = lds_byte(wr * 64 + fr, fq * 8), boff = lds_byte(wc * 32 + fr, fq * 8);
#define PG8_SA(b, h) (((b) * 2 + (h)) * HTB)
#define PG8_SB(b, h) ((4 + (b) * 2 + (h)) * HTB)
#define PG8_STAGE(bufoff, gbase, voff) do { _Pragma("unroll") for (int _i = 0; _i < 2; ++_i) \
        __builtin_amdgcn_global_load_lds((const unsigned*)((const char*)(gbase) + (voff)[_i]), (LAS unsigned*)(lds + (bufoff) + ldsw + _i * 8192), 16, 0, 0); } while (0)
#define PG8_LDA(dst, b, h) do { _Pragma("unroll") for (int m = 0; m < 4; ++m) _Pragma("unroll") for (int k = 0; k < 2; ++k) dst[m][k] = *(const LAS bf16x8*)(lds + PG8_SA(b, h) + aoff + m * 2048 + k * 1024); } while (0)
#define PG8_LDB(dst, b, h) do { _Pragma("unroll") for (int n = 0; n < 2; ++n) _Pragma("unroll") for (int k = 0; k < 2; ++k) dst[n][k] = *(const LAS bf16x8*)(lds + PG8_SB(b, h) + boff + n * 2048 + k * 1024); } while (0)
#define PG8_MMA(ai, bj, At, Bt) do { __builtin_amdgcn_s_setprio(1); _Pragma("unroll") for (int m = 0; m < 4; ++m) _Pragma("unroll") for (int n = 0; n < 2; ++n) _Pragma("unroll") for (int k = 0; k < 2; ++k) \
        acc[ai][bj][m][n] = __builtin_amdgcn_mfma_f32_16x16x32_bf16(Bt[n][k], At[m][k], acc[ai][bj][m][n], 0, 0, 0); __builtin_amdgcn_s_setprio(0); } while (0)
#define PG8_WAIT_V(n) asm volatile("s_waitcnt vmcnt(" #n ")" ::: "memory")
#define PG8_WAIT_L(n) asm volatile("s_waitcnt lgkmcnt(" #n ")" ::: "memory")
#define PG8_BAR __builtin_amdgcn_s_barrier()
#define PG8_SCHED __builtin_amdgcn_sched_barrier(0)
    Unit cur, nxt; int ui = 0;
    if (!S.next(0, cur)) return;
    f32x4 acc[2][2][4][2];
#pragma unroll
    for (int a = 0; a < 2; ++a)
#pragma unroll
        for (int b = 0; b < 2; ++b)
#pragma unroll
            for (int m = 0; m < 4; ++m)
#pragma unroll
                for (int n = 0; n < 2; ++n) acc[a][b][m][n] = (f32x4){0.f, 0.f, 0.f, 0.f};
    bf16x8 At[4][2], B0[2][2], B1[2][2];
    const char* cA = g.a_ptr(cur); const char* cB = g.b_ptr(cur);
    PG8_STAGE(PG8_SB(0, 0), cB, voffB); PG8_STAGE(PG8_SB(0, 1), cB + hB, voffB); PG8_STAGE(PG8_SA(0, 0), cA, voffA); PG8_STAGE(PG8_SA(0, 1), cA + hA, voffA);
    if (wr == 1) PG8_BAR;
    PG8_WAIT_V(2); PG8_BAR;
    PG8_STAGE(PG8_SB(1, 0), cB + kstep, voffB); PG8_STAGE(PG8_SA(1, 0), cA + kstep, voffA); PG8_STAGE(PG8_SB(1, 1), cB + hB + kstep, voffB);
    PG8_WAIT_V(6); PG8_BAR;
    for (;;) {
        const bool has_next = S.next(ui + 1, nxt);
        const char* nA = has_next ? g.a_ptr(nxt) : cA; const char* nB = has_next ? g.b_ptr(nxt) : cB;
        for (int t = 0; t < nt; t += 2) {
            const bool last = (t == nt - 2);
            const char* a1 = cA + (size_t)(t + 1) * kstep;
            const char* a2 = last ? nA : cA + (size_t)(t + 2) * kstep; const char* b2 = last ? nB : cB + (size_t)(t + 2) * kstep;
            const char* a3 = a2 + kstep; const char* b3 = b2 + kstep;
            PG8_LDB(B0, 0, 0); PG8_LDB(B1, 0, 1); PG8_SCHED; PG8_LDA(At, 0, 0); PG8_STAGE(PG8_SA(1, 1), a1 + hA, voffA);
            PG8_WAIT_V(8); PG8_WAIT_L(0); PG8_BAR; PG8_MMA(0, 0, At, B0); PG8_MMA(0, 1, At, B1); PG8_BAR; PG8_SCHED;
            PG8_LDA(At, 0, 1); PG8_STAGE(PG8_SB(0, 0), b2, voffB); PG8_STAGE(PG8_SB(0, 1), b2 + hB, voffB); PG8_STAGE(PG8_SA(0, 0), a2, voffA);
            PG8_WAIT_V(8); PG8_WAIT_L(0); PG8_BAR; PG8_MMA(1, 0, At, B0); PG8_MMA(1, 1, At, B1); PG8_BAR; PG8_SCHED;
            PG8_LDB(B0, 1, 0); PG8_LDB(B1, 1, 1); PG8_SCHED; PG8_LDA(At, 1, 0); PG8_STAGE(PG8_SA(0, 1), a2 + hA, voffA);
            PG8_WAIT_V(8); PG8_WAIT_L(0); PG8_BAR; PG8_MMA(0, 0, At, B0); PG8_MMA(0, 1, At, B1); PG8_BAR; PG8_SCHED;
            PG8_LDA(At, 1, 1); PG8_STAGE(PG8_SB(1, 0), b3, voffB); PG8_STAGE(PG8_SB(1, 1), b3 + hB, voffB); PG8_STAGE(PG8_SA(1, 0), a3, voffA);
            PG8_WAIT_V(8); PG8_WAIT_L(0); PG8_BAR; PG8_MMA(1, 0, At, B0); PG8_MMA(1, 1, At, B1); PG8_BAR; PG8_SCHED;
        }
        if (wr == 0) PG8_BAR;
        E(acc, cur, wr, wc, fr, fq, lds + XS_OFF);
        if (!has_next) break;
#pragma unroll
        for (int a = 0; a < 2; ++a)
#pragma unroll
            for (int b = 0; b < 2; ++b)
#pragma unroll
                for (int m = 0; m < 4; ++m)
#pragma unroll
                    for (int n = 0; n < 2; ++n) acc[a][b][m][n] = (f32x4){0.f, 0.f, 0.f, 0.f};
        cur = nxt; cA = nA; cB = nB; ++ui;
        if (wr == 1) PG8_BAR;
    }
    PG8_WAIT_V(0);
    PG8_BAR;
#undef PG8_SA
#undef PG8_SB
#undef PG8_STAGE
#undef PG8_LDA
#undef PG8_LDB
#undef PG8_MMA
#undef PG8_WAIT_V
#undef PG8_WAIT_L
#undef PG8_BAR
#undef PG8_SCHED
}
}

struct Params {
    const float* in[31];
    float* out;
    unsigned char* ws;
    int ph_lo, ph_hi;
};
enum { I_X = 0, I_MEM, I_RELB, I_MIXPRE, I_MIXPOST, I_WIN, I_POOLW, I_POOLS, I_CONVW, I_CONVB, I_CLNG, I_CLNB, I_CPW, I_CKPOS, I_CKW1, I_CKW2,
       I_CVPOS, I_CVW1, I_CVW2, I_WOUT, I_XAPRE, I_XAPOST, I_MEMG, I_WQ, I_WK, I_WV, I_WO, I_MLPPRE, I_MLPPOST, I_W1, I_W2 };

__device__ __forceinline__ void tr_item(const float* W, int K, int N, int Npad, bf16_t* WT, LAS float* scr, int item, int lane) {
    const int nblk = Npad / 32, kb = item / nblk, nb = item % nblk, k0 = 64 * kb, n0 = 32 * nb;
    const int nn = n0 + (lane & 31);
#pragma unroll 8
    for (int i = 0; i < 32; ++i) { const int kk = 2 * i + (lane >> 5); scr[kk * 33 + (lane & 31)] = (nn < N) ? W[(size_t)(k0 + kk) * N + nn] : 0.f; }
    asm volatile("s_waitcnt lgkmcnt(0)" ::: "memory");
    const int c = lane & 7;
#pragma unroll
    for (int j = 0; j < 4; ++j) { const int n = (lane >> 3) + 8 * j; const LAS float* s = scr + (8 * c) * 33 + n;
        u32x4 o; o.x = pk2(s[0 * 33], s[1 * 33]); o.y = pk2(s[2 * 33], s[3 * 33]); o.z = pk2(s[4 * 33], s[5 * 33]); o.w = pk2(s[6 * 33], s[7 * 33]);
        *(u32x4*)(WT + (size_t)(n0 + n) * K + k0 + 8 * c) = o; }
    asm volatile("s_waitcnt lgkmcnt(0)" ::: "memory");
}
__device__ __forceinline__ void rms_row_to_bf16(const float* xrow, const float* g, bf16_t* orow, int lane) {
    const f32x4* xr = (const f32x4*)xrow + lane; const f32x4* gr = (const f32x4*)g + lane;
    f32x4 v[4]; float s = 0.f;
#pragma unroll
    for (int j = 0; j < 4; ++j) { v[j] = xr[64 * j]; s += (v[j].x * v[j].x + v[j].y * v[j].y) + (v[j].z * v[j].z + v[j].w * v[j].w); }
    const float rstd = 1.f / sqrtf(wave_sum(s) * (1.f / DM) + EPS);
    u32x2* o8 = (u32x2*)orow + lane;
#pragma unroll
    for (int j = 0; j < 4; ++j) { const f32x4 gg = gr[64 * j]; u32x2 w; w.x = pk2(v[j].x * rstd * gg.x, v[j].y * rstd * gg.y); w.y = pk2(v[j].z * rstd * gg.z, v[j].w * rstd * gg.w); o8[64 * j] = w; }
}

__device__ __forceinline__ void prologue_phase(const Params& p, LAS unsigned char* lds, int vcu, int G) {
    const int tid = opaque_tid(), lane = tid & 63, wave = tid >> 6;
    LAS float* scr = (LAS float*)(lds + wave * 16384);
    const int gw = vcu * 8 + wave, NGW = G * 8;
    unsigned char* ws = p.ws;
    constexpr int I_IN = 16 * 72, I_SQ = 16 * 32, I_1 = 16 * 128, I_2 = 64 * 32, I_C1 = 32 * 8, I_C2 = 4 * 8, I_PW = 4 * 8;
    constexpr int PER_L = I_IN + 5 * I_SQ + I_1 + I_2 + 2 * I_C1 + 2 * I_C2 + I_PW;
    for (int it = gw; it < 2 * PER_L; it += NGW) {
        const int l = it / PER_L; int r = it % PER_L; unsigned char* wl = ws + WS_W + (size_t)l * WS_WL;
        if (r < I_IN) { tr_item(p.in[I_WIN] + (size_t)l * DM * 2072, DM, 2072, DINP, (bf16_t*)(wl + W_IN), scr, r, lane); continue; } r -= I_IN;
        if (r < I_SQ) { tr_item(p.in[I_WOUT] + (size_t)l * DM * DM, DM, DM, DM, (bf16_t*)(wl + W_OUT), scr, r, lane); continue; } r -= I_SQ;
        if (r < I_SQ) { tr_item(p.in[I_WQ] + (size_t)l * DM * DM, DM, DM, DM, (bf16_t*)(wl + W_Q), scr, r, lane); continue; } r -= I_SQ;
        if (r < I_SQ) { tr_item(p.in[I_WO] + (size_t)l * DM * DM, DM, DM, DM, (bf16_t*)(wl + W_O), scr, r, lane); continue; } r -= I_SQ;
        if (r < I_SQ) { tr_item(p.in[I_WK] + (size_t)l * DM * DM, DM, DM, DM, (bf16_t*)(wl + W_K), scr, r, lane); continue; } r -= I_SQ;
        if (r < I_SQ) { tr_item(p.in[I_WV] + (size_t)l * DM * DM, DM, DM, DM, (bf16_t*)(wl + W_V), scr, r, lane); continue; } r -= I_SQ;
        if (r < I_1) { tr_item(p.in[I_W1] + (size_t)l * DM * FF, DM, FF, FF, (bf16_t*)(wl + W_1), scr, r, lane); continue; } r -= I_1;
        if (r < I_2) { tr_item(p.in[I_W2] + (size_t)l * FF * DM, FF, DM, DM, (bf16_t*)(wl + W_2), scr, r, lane); continue; } r -= I_2;
        if (r < I_C1) { tr_item(p.in[I_CKW1] + (size_t)l * 2048 * 256, 2048, 256, 256, (bf16_t*)(wl + W_CK1), scr, r, lane); continue; } r -= I_C1;
        if (r < I_C1) { tr_item(p.in[I_CVW1] + (size_t)l * 2048 * 256, 2048, 256, 256, (bf16_t*)(wl + W_CV1), scr, r, lane); continue; } r -= I_C1;
        if (r < I_C2) { tr_item(p.in[I_CKW2] + (size_t)l * 256 * 64, 256, 64, 256, (bf16_t*)(wl + W_CK2), scr, r, lane); continue; } r -= I_C2;
        if (r < I_C2) { tr_item(p.in[I_CVW2] + (size_t)l * 256 * 64, 256, 64, 256, (bf16_t*)(wl + W_CV2), scr, r, lane); continue; } r -= I_C2;
        tr_item(p.in[I_CPW] + (size_t)l * 256 * 256, 256, 256, 256, (bf16_t*)(wl + W_CPW), scr, r, lane);
    }
    for (int e = vcu * 512 + tid; e < 2 * 65536; e += G * 512) {
        const int l = e >> 16, n = (e >> 8) & 255, k = e & 255;
        float v = 0.f;
        if ((n >> 6) == (k >> 6)) v = p.in[I_POOLW][(size_t)l * 16384 + (n >> 6) * 4096 + (k & 63) * 64 + (n & 63)] * p.in[I_POOLS][l * 256 + n];
        ((bf16_t*)(ws + WS_W + (size_t)l * WS_WL + W_POOL))[n * 256 + k] = (bf16_t)f2bf(v);
    }
    for (int it = vcu; it < 16; it += G) {
        const int l = it >> 3, kv = (it >> 2) & 1, nc = it & 3;
        const float* pos = p.in[kv ? I_CVPOS : I_CKPOS] + (size_t)l * 2048;
        const float* w1 = p.in[kv ? I_CVW1 : I_CKW1] + (size_t)l * 2048 * 256;
        const int ks = tid >> 6, n = nc * 64 + (tid & 63);
        float a = 0.f;
        for (int k = ks * 256; k < ks * 256 + 256; ++k) a += pos[k] * w1[(size_t)k * 256 + n];
        LAS float* red = (LAS float*)(lds + 131072);
        red[ks * 64 + (tid & 63)] = a;
        __syncthreads();
        if (tid < 64) { float s = 0.f;
#pragma unroll
            for (int q = 0; q < 8; ++q) s += red[q * 64 + tid];
            ((float*)(ws + WS_W + (size_t)l * WS_WL + (kv ? W_CB1V : W_CB1K)))[nc * 64 + tid] = s; }
        __syncthreads();
    }
    for (int m = gw; m < 2 * NB * NMEM; m += NGW) { const int l = m / (NB * NMEM), r = m % (NB * NMEM);
        rms_row_to_bf16(p.in[I_MEM] + (size_t)r * DM, p.in[I_MEMG] + l * DM, (bf16_t*)(ws + WS_W + (size_t)l * WS_WL + W_MEMN) + (size_t)r * DM, lane); }
    for (int m = gw; m < MTOK; m += NGW) rms_row_to_bf16(p.in[I_X] + (size_t)m * DM, p.in[I_MIXPRE], (bf16_t*)(ws + WS_XN) + (size_t)m * DM, lane);
}

__device__ __forceinline__ void rowwise_phase(const float* xsrc, float* xdst, const bf16_t* mix, const float* gpost, const float* gnext, bf16_t* xn, int vcu, int G) {
    const int tid = opaque_tid(), lane = tid & 63, wave = tid >> 6;
    const int gw = vcu * 8 + wave, NGW = G * 8;
    for (int m = gw; m < MTOK; m += NGW) {
        const f32x4* xr = (const f32x4*)(xsrc + (size_t)m * DM) + lane; const u32x2* mr = (const u32x2*)(mix + (size_t)m * DM) + lane;
        f32x4 y[4], x[4]; float s = 0.f;
#pragma unroll
        for (int j = 0; j < 4; ++j) { const u32x2 w = mr[64 * j]; x[j] = xr[64 * j];
            y[j].x = __builtin_bit_cast(float, w.x << 16); y[j].y = __builtin_bit_cast(float, w.x & 0xffff0000u); y[j].z = __builtin_bit_cast(float, w.y << 16); y[j].w = __builtin_bit_cast(float, w.y & 0xffff0000u);
            s += (y[j].x * y[j].x + y[j].y * y[j].y) + (y[j].z * y[j].z + y[j].w * y[j].w); }
        const float rstd = 1.f / sqrtf(wave_sum(s) * (1.f / DM) + EPS);
        float s2 = 0.f;
#pragma unroll
        for (int j = 0; j < 4; ++j) { const f32x4 gg = ((const f32x4*)gpost)[lane + 64 * j]; x[j] = x[j] + y[j] * rstd * gg;
            s2 += (x[j].x * x[j].x + x[j].y * x[j].y) + (x[j].z * x[j].z + x[j].w * x[j].w);
            ((f32x4*)(xdst + (size_t)m * DM))[lane + 64 * j] = x[j]; }
        if (gnext) {
            const float r2 = 1.f / sqrtf(wave_sum(s2) * (1.f / DM) + EPS);
            u32x2* o8 = (u32x2*)(xn + (size_t)m * DM) + lane;
#pragma unroll
            for (int j = 0; j < 4; ++j) { const f32x4 gg = ((const f32x4*)gnext)[lane + 64 * j]; u32x2 w; w.x = pk2(x[j].x * r2 * gg.x, x[j].y * r2 * gg.y); w.y = pk2(x[j].z * r2 * gg.z, x[j].w * r2 * gg.w); o8[64 * j] = w; }
        }
    }
}

__device__ __forceinline__ void prep_phase(const Params& p, int l, LAS unsigned char* lds, int vcu, int G) {
    const int tid = opaque_tid(), lane = tid & 63, wave = tid >> 6;
    const bf16_t* PROJ = (const bf16_t*)(p.ws + WS_PROJ); bf16_t* ACT = (bf16_t*)(p.ws + WS_ACT);
    bf16_t* KCR = (bf16_t*)(p.ws + WS_KCRAW); bf16_t* VCR = (bf16_t*)(p.ws + WS_VCRAW);
    LAS bf16_t* hT = (LAS bf16_t*)lds;
    LAS float* cv = (LAS float*)(lds + 49152);
    const float* cw = p.in[I_CONVW] + (size_t)l * 31 * 256; const float* cb = p.in[I_CONVB] + l * 256;
    const float* lg = p.in[I_CLNG] + l * 256; const float* lb = p.in[I_CLNB] + l * 256;
    for (int u = vcu; u < MTOK / 64; u += G) {
        const int b = u >> 7, t0 = (u & 127) * 64; const size_t R0 = (size_t)b * SEQ + t0;
        for (int it = tid; it < 94 * 32; it += 512) { const int jr = it >> 5, ch = (it & 31) * 8; const int t = t0 - 30 + jr;
            u32x4 o = (u32x4){0u, 0u, 0u, 0u};
            if (t >= 0) { const bf16_t* rp = PROJ + ((size_t)b * SEQ + t) * DINP; const u32x4 a = *(const u32x4*)(rp + 256 + ch), gt = *(const u32x4*)(rp + 512 + ch);
#pragma unroll
                for (int e = 0; e < 4; ++e) { const unsigned aw = a[e], gw_ = gt[e];
                    const float a0 = __builtin_bit_cast(float, aw << 16), a1 = __builtin_bit_cast(float, aw & 0xffff0000u), g0 = __builtin_bit_cast(float, gw_ << 16), g1 = __builtin_bit_cast(float, gw_ & 0xffff0000u);
                    o[e] = pk2(a0 / (1.f + __expf(-g0)), a1 / (1.f + __expf(-g1))); } }
            *(LAS u32x4*)(hT + jr * 256 + ch) = o; }
        { const int c = tid & 255, half = tid >> 8; const int w = 2 << (c >> 6);
          const bf16_t* up = PROJ + (size_t)b * SEQ * DINP + c;
          float sum = 0.f; const int ts = t0 + half * 32;
          for (int d = 1; d < w; ++d) { const int t = ts - d; if (t >= 0) sum += bf2f(up[(size_t)t * DINP]); }
          for (int i = 0; i < 32; ++i) { const int t = ts + i; const float ut = bf2f(up[(size_t)t * DINP]); sum += ut;
              const int cnt = (t + 1 < w) ? (t + 1) : w; const float d = sum / (float)cnt - ut;
              ACT[((size_t)b * SEQ + t) * 512 + c] = (bf16_t)f2bf(d);
              const int tb = t - w + 1; if (tb >= 0) sum -= bf2f(up[(size_t)tb * DINP]); } }
        for (int it = tid; it < 64 * 32; it += 512) { const int i = it >> 5, cc = it & 31; const int which = cc >> 4, g = (cc >> 3) & 1, d8 = (cc & 7) * 8;
            const u32x4 v = *(const u32x4*)(PROJ + (R0 + i) * DINP + 1280 + cc * 8);
            bf16_t* dst = (which ? VCR : KCR) + (((size_t)(b * 2 + g) * SEQ + t0 + i) * 64 + d8); *(u32x4*)dst = v; }
        __syncthreads();
        { const int c = tid & 255, half = tid >> 8; float wv[31];
#pragma unroll
          for (int k = 0; k < 31; ++k) wv[k] = cw[k * 256 + c];
          const float bias = cb[c];
          for (int i = half * 32; i < half * 32 + 32; ++i) { float a = bias;
#pragma unroll
              for (int k = 0; k < 31; ++k) a += wv[k] * bf2f(hT[(i + k) * 256 + c]);
              cv[i * 256 + c] = a; } }
        __syncthreads();
        for (int i = wave * 8; i < wave * 8 + 8; ++i) { const f32x4 x = *(LAS f32x4*)(cv + i * 256 + lane * 4);
            const float mu = wave_sum((x.x + x.y) + (x.z + x.w)) * (1.f / 256.f);
            const f32x4 dd = x - mu; const float var = wave_sum((dd.x * dd.x + dd.y * dd.y) + (dd.z * dd.z + dd.w * dd.w)) * (1.f / 256.f);
            const float rs = 1.f / sqrtf(var + EPS); const f32x4 gg = *(const f32x4*)(lg + lane * 4), bb = *(const f32x4*)(lb + lane * 4);
            f32x4 y = dd * rs * gg + bb;
#pragma unroll
            for (int e = 0; e < 4; ++e) y[e] = y[e] / (1.f + __expf(-y[e]));
            u32x2 w; w.x = pk2(y.x, y.y); w.y = pk2(y.z, y.w);
            *(u32x2*)(ACT + (R0 + i) * 512 + 256 + lane * 4) = w; }
        __syncthreads();
    }
}

namespace nsa {
constexpr int KB0 = 0, VB0 = 16384, LUT_OFF = 32768, WSF_OFF = 35840, SEL_OFF = 36864, IMP_OFF = 38912, OST_OFF = 72192, IMP_PITCH = 129, LUT_PITCH = 132;
__device__ __forceinline__ int crow(int r, int hi) { return (r & 3) + 8 * (r >> 2) + 4 * hi; }
__device__ __forceinline__ int rel_bucket_dev(int n) {
    if (n < 16) return n;
    const float v = logf((float)n / 16.f) / 2.0794415416798357f * 16.f;
    const int b = 16 + (int)v; return b < 31 ? b : 31;
}
__device__ __forceinline__ s16x4 vtr(LAS const char* p) { return __builtin_bit_cast(s16x4, __builtin_amdgcn_ds_read_tr16_b64_v4i16((LAS s16x4*)p)); }

struct TileRegs { u32x4 k, v; };
__device__ __forceinline__ void gload(TileRegs& R, const bf16_t* Kg, const bf16_t* Vg, int pitch, int tile, int wid, int lane) {
    R.k = *(const u32x4*)(Kg + (size_t)(tile * 64 + lane) * pitch + wid * 8);
    R.v = *(const u32x4*)(Vg + (size_t)(tile * 64 + 16 * (wid & 3) + (lane >> 2)) * pitch + (wid >> 2) * 32 + (lane & 3) * 8);
}
__device__ __forceinline__ void lstore(const TileRegs& R, LAS unsigned char* lds, int buf, int wid, int lane) {
    *(LAS u32x4*)(lds + KB0 + buf * 8192 + wid * 1024 + lane * 16) = R.k;
    *(LAS u32x4*)(lds + VB0 + buf * 8192 + wid * 1024 + lane * 16) = R.v;
}

template <int BR>
__device__ __forceinline__ void tile_compute(LAS unsigned char* lds, int buf, const bf16x8 (&qr)[4], f32x16 (&o)[2], float& m, float& l, float linv,
                                             int Dbase, bool general, float farb, LAS const float* lutr, bool rowvalid, int tok, int mbase, float& carry, int lane, int wid) {
    const int r32 = lane & 31, hi = lane >> 5;
    constexpr int KS = (BR <= 1) ? 16 : 1;
    f32x16 p0 = {}, p1 = {};
    { LAS const char* kb = (LAS const char*)(lds + KB0 + buf * 8192 + hi * 1024 + r32 * 16);
#pragma unroll
      for (int d0 = 0; d0 < 4; ++d0) { const bf16x8 b0 = *(LAS const bf16x8*)(kb + d0 * 2048), b1 = *(LAS const bf16x8*)(kb + d0 * 2048 + 512);
          p0 = __builtin_amdgcn_mfma_f32_32x32x16_bf16(b0, qr[d0], p0, 0, 0, 0); p1 = __builtin_amdgcn_mfma_f32_32x32x16_bf16(b1, qr[d0], p1, 0, 0, 0); } }
    if (general) {
#pragma unroll
        for (int r = 0; r < 16; ++r) { const int kv = crow(r, hi); const int d0 = Dbase - KS * kv, d1 = d0 - KS * 32;
            bool v0 = d0 >= 0 && rowvalid, v1 = d1 >= 0 && rowvalid; if (BR == 3) { v0 = v0 && d0 < 512; v1 = v1 && d1 < 512; }
            const int i0 = d0 < 0 ? 0 : (d0 > 128 ? 128 : d0), i1 = d1 < 0 ? 0 : (d1 > 128 ? 128 : d1);
            p0[r] = v0 ? p0[r] + lutr[i0] : NEGV; p1[r] = v1 ? p1[r] + lutr[i1] : NEGV; }
    } else {
#pragma unroll
        for (int r = 0; r < 16; ++r) { p0[r] = rowvalid ? p0[r] + farb : NEGV; p1[r] = rowvalid ? p1[r] + farb : NEGV; }
    }
    if (BR == 1) {
#pragma unroll
        for (int r = 0; r < 16; ++r) { p0[r] = ex2(p0[r] - m) * linv; p1[r] = ex2(p1[r] - m) * linv; }
        LAS float* IMP = (LAS float*)(lds + IMP_OFF) + tok * IMP_PITCH;
        float px[4], py[4];
#pragma unroll
        for (int k = 0; k < 4; ++k) { px[k] = __shfl_xor(p0[4 * k + 3], 32); py[k] = __shfl_xor(p1[4 * k + 3], 32); }
#pragma unroll
        for (int k = 0; k < 4; ++k) {
            const float pv0 = hi ? px[k] : (k == 0 ? carry : px[k > 0 ? k - 1 : 0]);
            const float pv1 = hi ? py[k] : (k == 0 ? px[3] : py[k > 0 ? k - 1 : 0]);
            float g0 = (p0[4 * k] + p0[4 * k + 1]) + (p0[4 * k + 2] + p0[4 * k + 3]) + pv0;
            float g1 = (p1[4 * k] + p1[4 * k + 1]) + (p1[4 * k + 2] + p1[4 * k + 3]) + pv1;
            g0 += __shfl_xor(g0, 1); g0 += __shfl_xor(g0, 2); g1 += __shfl_xor(g1, 1); g1 += __shfl_xor(g1, 2);
            if ((r32 & 3) == 0) { const int mi = mbase + 2 * k + hi; IMP[mi] = g0; IMP[mi + 8] = g1; }
        }
        carry = py[3];
    } else {
        float mx = NEGV;
#pragma unroll
        for (int r = 0; r < 16; ++r) mx = fmaxf(mx, fmaxf(p0[r], p1[r]));
        mx = fmaxf(mx, __shfl_xor(mx, 32));
        const float mn = fmaxf(m, mx); const float alpha = ex2(m - mn); m = mn;
        float sm = 0.f;
#pragma unroll
        for (int r = 0; r < 16; ++r) { p0[r] = ex2(p0[r] - mn); p1[r] = ex2(p1[r] - mn); sm += p0[r] + p1[r]; }
        l = l * alpha + sm;
        if (BR >= 2) {
            if (__any(alpha != 1.f)) {
                LAS float* wsf = (LAS float*)(lds + WSF_OFF) + wid * 32;
                if (hi == 0) wsf[r32] = alpha;
                asm volatile("s_waitcnt lgkmcnt(0)" ::: "memory");
#pragma unroll
                for (int r = 0; r < 16; ++r) { const float a = wsf[crow(r, hi)]; o[0][r] *= a; o[1][r] *= a; }
                asm volatile("s_waitcnt lgkmcnt(0)" ::: "memory");
            }
        }
    }
    if (BR >= 1) {
        u32x4 pw[4];
        pw[0] = (u32x4){cvt_pk_bf16(p0[0], p0[1]), cvt_pk_bf16(p0[2], p0[3]), cvt_pk_bf16(p0[4], p0[5]), cvt_pk_bf16(p0[6], p0[7])};
        pw[1] = (u32x4){cvt_pk_bf16(p0[8], p0[9]), cvt_pk_bf16(p0[10], p0[11]), cvt_pk_bf16(p0[12], p0[13]), cvt_pk_bf16(p0[14], p0[15])};
        pw[2] = (u32x4){cvt_pk_bf16(p1[0], p1[1]), cvt_pk_bf16(p1[2], p1[3]), cvt_pk_bf16(p1[4], p1[5]), cvt_pk_bf16(p1[6], p1[7])};
        pw[3] = (u32x4){cvt_pk_bf16(p1[8], p1[9]), cvt_pk_bf16(p1[10], p1[11]), cvt_pk_bf16(p1[12], p1[13]), cvt_pk_bf16(p1[14], p1[15])};
        LAS const char* vp = (LAS const char*)(lds + VB0 + buf * 8192 + ((lane >> 4) & 1) * 32 + (lane & 3) * 8 + (4 * hi + ((lane & 15) >> 2)) * 64);
#pragma unroll
        for (int d0 = 0; d0 < 2; ++d0)
#pragma unroll
            for (int ks = 0; ks < 4; ++ks) { const s16x4 lo = vtr(vp + d0 * 4096 + ks * 1024), hh = vtr(vp + d0 * 4096 + ks * 1024 + 512);
                const bf16x8 vf = (bf16x8){lo[0], lo[1], lo[2], lo[3], hh[0], hh[1], hh[2], hh[3]};
                o[d0] = __builtin_amdgcn_mfma_f32_32x32x16_bf16(__builtin_bit_cast(bf16x8, pw[ks]), vf, o[d0], 0, 0, 0); }
    }
}

__device__ __forceinline__ void accum_branch(LAS unsigned char* lds, f32x16 (&o)[2], float fac, bool first, int lane, int wid) {
    const int r32 = lane & 31, hi = lane >> 5;
    LAS float* wsf = (LAS float*)(lds + WSF_OFF) + wid * 32;
    LAS float* st = (LAS float*)(lds + OST_OFF) + wid * 2048 + lane;
    if (hi == 0) wsf[r32] = fac;
    asm volatile("s_waitcnt lgkmcnt(0)" ::: "memory");
#pragma unroll
    for (int r = 0; r < 16; ++r) { const float a = wsf[crow(r, hi)];
        float v0 = o[0][r] * a, v1 = o[1][r] * a;
        if (!first) { v0 += st[(r * 2) * 64]; v1 += st[(r * 2 + 1) * 64]; }
        st[(r * 2) * 64] = v0; st[(r * 2 + 1) * 64] = v1; }
    asm volatile("s_waitcnt lgkmcnt(0)" ::: "memory");
}

template <int BR>
__device__ __forceinline__ void run_branch(LAS unsigned char* lds, const bf16_t* Kg, const bf16_t* Vg, int pitch, int first, int step, int n,
                                           const bf16x8 (&qr)[4], f32x16 (&o)[2], float& m, float& l, float linv,
                                           int t0, int qt, int tok, int head, int lane, int wid) {
    TileRegs R; float carry = 0.f;
    gload(R, Kg, Vg, pitch, first, wid, lane); lstore(R, lds, 0, wid, lane);
    __syncthreads();
    LAS const float* lutr = (LAS const float*)(lds + LUT_OFF) + head * LUT_PITCH;
    const float farb = lutr[128];
    LAS const unsigned* selw = (LAS const unsigned*)(lds + SEL_OFF) + tok * 4;
    for (int k = 0; k < n; ++k) {
        const int tile = first + k * step;
        if (k + 1 < n) gload(R, Kg, Vg, pitch, tile + step, wid, lane);
        int Dbase; bool general; bool rowvalid = true;
        if (BR <= 1) { Dbase = t0 + tok - 31 - 16 * 64 * tile; general = (t0 - 16 * (64 * tile + 63) - 31) < 128; }
        else { Dbase = 64 * (qt - tile) + tok; general = (qt - tile) <= 2 || (BR == 3 && (qt - tile) >= 8); }
        if (BR == 2) rowvalid = (selw[tile >> 5] >> (tile & 31)) & 1u;
        if (BR != 2 || __any(rowvalid))
            tile_compute<BR>(lds, k & 1, qr, o, m, l, linv, Dbase, general, farb, lutr, rowvalid, tok, tile * 16, carry, lane, wid);
        if (k + 1 < n) lstore(R, lds, (k + 1) & 1, wid, lane);
        __syncthreads();
    }
}

__device__ __forceinline__ void nsa_unit(const Params& p, int l, LAS unsigned char* lds, int b, int g, int qt) {
    const int tid = opaque_tid(), lane = tid & 63, wid = __builtin_amdgcn_readfirstlane(tid >> 6), r32 = lane & 31, hi = lane >> 5;
    const bf16_t* PROJ = (const bf16_t*)(p.ws + WS_PROJ);
    const bf16_t* KC = (const bf16_t*)(p.ws + WS_KC) + (size_t)(b * 2 + g) * 512 * 256;
    const bf16_t* VC = (const bf16_t*)(p.ws + WS_VC) + (size_t)(b * 2 + g) * 512 * 256;
    bf16_t* CAT = (bf16_t*)(p.ws + WS_CAT);
    const int t0 = qt * 64; const size_t R0 = (size_t)b * SEQ;
    const int q = wid * 32 + r32, tok = q >> 2, head = q & 3;
    { LAS float* lut = (LAS float*)(lds + LUT_OFF);
      for (int e = tid; e < 4 * 129; e += 512) { const int r = e / 129, d = e % 129; const int bk = d >= 128 ? 31 : rel_bucket_dev(d);
          lut[r * LUT_PITCH + d] = p.in[I_RELB][bk * 8 + g * 4 + r] * LOG2E; }
      if (tid < 256) ((LAS unsigned*)(lds + SEL_OFF))[tid] = 0u; }
    const bf16_t* qrow = PROJ + (R0 + t0 + tok) * DINP;
    bf16x8 qr[4];
#pragma unroll
    for (int d0 = 0; d0 < 4; ++d0) qr[d0] = *(const bf16x8*)(qrow + 768 + (g * 4 + head) * 64 + d0 * 16 + hi * 8);
    float gate[3];
#pragma unroll
    for (int br = 0; br < 3; ++br) gate[br] = 1.f / (1.f + __expf(-bf2f(qrow[2048 + (g * 4 + head) * 3 + br])));
    __syncthreads();
    f32x16 o[2];
    const int nct = (4 * qt + 3 + 63) / 64;
    float mc = NEGV, lc = 0.f;
    o[0] = f32x16{}; o[1] = f32x16{};
    run_branch<0>(lds, KC, VC, 256, 0, 1, nct, qr, o, mc, lc, 0.f, t0, qt, tok, head, lane, wid);
    lc += __shfl_xor(lc, 32);
    const float linvc = (mc > -1e29f && lc > 0.f) ? 1.f / lc : 0.f;
    { float md = 0.f, ld = 0.f; float mcc = mc;
      run_branch<1>(lds, KC, VC, 256, 0, 1, nct, qr, o, mcc, ld, linvc, t0, qt, tok, head, lane, wid); (void)md; }
    accum_branch(lds, o, gate[0], true, lane, wid);
    __syncthreads();
    { LAS float* G = (LAS float*)(lds + IMP_OFF); LAS unsigned* selw = (LAS unsigned*)(lds + SEL_OFF);
      const int i = tid >> 3, sub = tid & 7; const int cur = qt;
      if (cur < 16) { if (sub == 0) { selw[i * 4 + 0] = 0xffffffffu; selw[i * 4 + 1] = 0xffffffffu; selw[i * 4 + 2] = 0xffffffffu; selw[i * 4 + 3] = 0xffffffffu; } }
      else {
          for (int mm = 0; mm < 16; ++mm) { const int j = sub + 8 * mm; if (j <= cur) { float sc;
              if (j == 0 || j == cur || j == cur - 1) G[i * IMP_PITCH + j] = 1e30f; } }
          __syncthreads();
          for (int mm = 0; mm < 16; ++mm) { const int j = sub + 8 * mm; if (j <= cur) { const float sj = G[i * IMP_PITCH + j]; int cnt = 0;
              for (int jj = 0; jj <= cur; ++jj) { const float s2 = G[i * IMP_PITCH + jj]; cnt += (s2 > sj || (s2 == sj && jj < j)) ? 1 : 0; }
              if (cnt < 16) atomicOr((unsigned*)&selw[i * 4 + (j >> 5)], 1u << (j & 31)); } }
      } }
    __syncthreads();
    { float ms = NEGV, ls = 0.f; o[0] = f32x16{}; o[1] = f32x16{};
      run_branch<2>(lds, PROJ + R0 * DINP + 1536 + g * 64, PROJ + R0 * DINP + 1664 + g * 64, DINP, qt, -1, qt + 1, qr, o, ms, ls, 0.f, t0, qt, tok, head, lane, wid);
      ls += __shfl_xor(ls, 32);
      accum_branch(lds, o, gate[1] / ls, false, lane, wid); }
    { float mw = NEGV, lw = 0.f; o[0] = f32x16{}; o[1] = f32x16{};
      const int nw = qt + 1 < 9 ? qt + 1 : 9;
      run_branch<3>(lds, PROJ + R0 * DINP + 1792 + g * 64, PROJ + R0 * DINP + 1920 + g * 64, DINP, qt, -1, nw, qr, o, mw, lw, 0.f, t0, qt, tok, head, lane, wid);
      lw += __shfl_xor(lw, 32);
      accum_branch(lds, o, gate[2] / lw, false, lane, wid); }
    { LAS const float* st = (LAS const float*)(lds + OST_OFF) + wid * 2048 + lane;
#pragma unroll
    for (int r = 0; r < 16; ++r) { const int qq = wid * 32 + crow(r, hi); const int tk = qq >> 2, hd = qq & 3;
        bf16_t* dst = CAT + (R0 + t0 + tk) * DM + 512 + (g * 4 + hd) * 64 + r32;
        dst[0] = (bf16_t)f2bf(st[(r * 2) * 64]); dst[32] = (bf16_t)f2bf(st[(r * 2 + 1) * 64]); } }
    __syncthreads();
}

__device__ __forceinline__ void nsa_phase(const Params& p, int l, LAS unsigned char* lds, int vcu, int G) {
    for (int v = vcu; v < 256; v += G) {
        const int bg = v >> 4, s = v & 15;
        for (int i = 0; i < 8; ++i) { const int qt = (i >> 1) * 32 + ((i & 1) ? 31 - s : s); nsa_unit(p, l, lds, bg >> 1, bg & 1, qt); }
    }
}
}

__global__ void __launch_bounds__(512) hybrid_fwd(Params p) {
    extern __shared__ __attribute__((aligned(16))) unsigned char lds_raw[];
    LAS unsigned char* lds = (LAS unsigned char*)lds_raw;
    cg::grid_group grid = cg::this_grid();
    const int G = gridDim.x, bx = blockIdx.x;
    const int vcu = (G % 8 == 0) ? (bx % 8) * (G / 8) + bx / 8 : bx;
    unsigned char* ws = p.ws;
    for (int ph = p.ph_lo; ph < p.ph_hi; ++ph) {
        if (ph == 0) prologue_phase(p, lds, vcu, G);
        else {
            const int l = (ph - 1) / 15, k = (ph - 1) % 15 + 1;
            unsigned char* wl = ws + WS_W + (size_t)l * WS_WL;
            int njobs = 0;
            if (k == 1) njobs = (l == 0) ? 5 : 1; else if (k == 3) njobs = 4; else if (k == 4) njobs = 2;
            else if (k == 6 || k == 8 || k == 9 || k == 10 || k == 11 || k == 13 || k == 14) njobs = 1;
            for (int job = 0; job < njobs; ++job) {
                pg8::Gemm g; pg8::Epi E; int M = MTOK, N = DM, c0 = 0;
                g.a_pn = 0; g.b_batch = 0; g.mtpb = 1 << 30; g.lda = DM; g.ldb = DM; g.K = DM;
                E.bias = nullptr; E.act = 0; E.sc_lo = 0; E.sc_hi = 0; E.sc = 1.f; E.ldc = DM;
                if (k == 1 && job == 0) { g.A = (const bf16_t*)(ws + WS_XN); g.Bt = (const bf16_t*)(wl + W_IN); N = DINP; E.O = (bf16_t*)(ws + WS_PROJ); E.ldc = DINP; E.sc_lo = 3; E.sc_hi = 5; E.sc = 0.125f * LOG2E; }
                else if (k == 1) { const int ll = (job - 1) >> 1; unsigned char* w2 = ws + WS_W + (size_t)ll * WS_WL;
                    if ((job - 1) & 1) { g.A = (const bf16_t*)(w2 + W_V); g.Bt = (const bf16_t*)(w2 + W_MEMN); M = DM; N = NB * NMEM; E.O = (bf16_t*)(ws + WS_VMT + (size_t)ll * 4 * MiB); E.ldc = NB * NMEM; }
                    else { g.A = (const bf16_t*)(w2 + W_MEMN); g.Bt = (const bf16_t*)(w2 + W_K); M = NB * NMEM; N = DM; E.O = (bf16_t*)(ws + WS_KM + (size_t)ll * 4 * MiB); }
                    c0 = 32 * (job - 1); }
                else if (k == 3 && job < 2) { g.A = (const bf16_t*)(ws + (job ? WS_VCRAW : WS_KCRAW)); g.lda = 1024; g.K = 2048; g.Bt = (const bf16_t*)(wl + (job ? W_CV1 : W_CK1)); g.ldb = 2048;
                    M = 8192; N = 256; E.O = (bf16_t*)(ws + (job ? WS_HIDV : WS_HIDK)); E.ldc = 256; E.act = 2; E.bias = (const float*)(wl + (job ? W_CB1V : W_CB1K)); c0 = job * 32; }
                else if (k == 3) { g.A = (const bf16_t*)(ws + WS_ACT) + (job == 3 ? 256 : 0); g.lda = 512; g.K = 256; g.Bt = (const bf16_t*)(wl + (job == 3 ? W_CPW : W_POOL)); g.ldb = 256;
                    N = 256; E.O = (bf16_t*)(ws + WS_CAT) + (job == 3 ? 256 : 0); c0 = 64; }
                else if (k == 4) { g.A = (const bf16_t*)(ws + (job ? WS_HIDV : WS_HIDK)); g.lda = 256; g.K = 256; g.Bt = (const bf16_t*)(wl + (job ? W_CV2 : W_CK2)); g.ldb = 256;
                    M = 8192; N = 256; E.O = (bf16_t*)(ws + (job ? WS_VC : WS_KC)); E.ldc = 256; c0 = job * 32; }
                else if (k == 6) { g.A = (const bf16_t*)(ws + WS_CAT); g.Bt = (const bf16_t*)(wl + W_OUT); E.O = (bf16_t*)(ws + WS_MIX); }
                else if (k == 8) { g.A = (const bf16_t*)(ws + WS_XN); g.Bt = (const bf16_t*)(wl + W_Q); E.O = (bf16_t*)(ws + WS_CAT); E.sc_lo = 0; E.sc_hi = 4; E.sc = 0.0625f * LOG2E; }
                else if (k == 9) { g.A = (const bf16_t*)(ws + WS_CAT); g.a_pn = 256; g.K = 256; g.Bt = (const bf16_t*)(ws + WS_KM + (size_t)l * 4 * MiB); g.b_pn = 256; g.b_batch = (size_t)NMEM * DM; g.mtpb = 32;
                    E.O = (bf16_t*)(ws + WS_PROJ); E.act = 3; }
                else if (k == 10) { g.A = (const bf16_t*)(ws + WS_PROJ); g.a_pn = 256; g.K = 256; g.Bt = (const bf16_t*)(ws + WS_VMT + (size_t)l * 4 * MiB); g.ldb = NB * NMEM; g.b_pn = (size_t)256 * NB * NMEM; g.b_batch = 256; g.mtpb = 32;
                    E.O = (bf16_t*)(ws + WS_CAT); }
                else if (k == 11) { g.A = (const bf16_t*)(ws + WS_CAT); g.Bt = (const bf16_t*)(wl + W_O); E.O = (bf16_t*)(ws + WS_MIX); }
                else if (k == 13) { g.A = (const bf16_t*)(ws + WS_XN); g.Bt = (const bf16_t*)(wl + W_1); N = FF; E.O = (bf16_t*)(ws + WS_HID); E.ldc = FF; E.act = 1; }
                else { g.A = (const bf16_t*)(ws + WS_HID); g.lda = FF; g.K = FF; g.Bt = (const bf16_t*)(wl + W_2); g.ldb = FF; E.O = (bf16_t*)(ws + WS_MIX); }
                if (!(k == 9 || k == 10)) g.b_pn = (size_t)256 * g.ldb;
                pg8::StaticOrder S; S.init(M, N, G, (bx - c0 + 4 * G) % G);
                pg8::gemm_phase(lds, g, S, E);
            }
            if (k == 2) prep_phase(p, l, lds, vcu, G);
            else if (k == 5) nsa::nsa_phase(p, l, lds, vcu, G);
            else if (k == 7) rowwise_phase(l == 0 ? p.in[I_X] : p.out, p.out, (const bf16_t*)(ws + WS_MIX), p.in[I_MIXPOST] + l * DM, p.in[I_XAPRE] + l * DM, (bf16_t*)(ws + WS_XN), vcu, G);
            else if (k == 12) rowwise_phase(p.out, p.out, (const bf16_t*)(ws + WS_MIX), p.in[I_XAPOST] + l * DM, p.in[I_MLPPRE] + l * DM, (bf16_t*)(ws + WS_XN), vcu, G);
            else if (k == 15) rowwise_phase(p.out, p.out, (const bf16_t*)(ws + WS_MIX), p.in[I_MLPPOST] + l * DM, l == 0 ? p.in[I_MIXPRE] + DM : nullptr, (bf16_t*)(ws + WS_XN), vcu, G);
        }
        if (ph + 1 < p.ph_hi) grid.sync();
    }
}

extern "C" void kernel_launch(void* const* d_in, const int* in_sizes, int n_in, void* d_out, int out_size, void* d_ws, size_t ws_size, hipStream_t stream) {
    static int grid = 0;
    if (grid == 0) {
        if (n_in != 31 || ws_size < WS_END) { fprintf(stderr, "kernel_launch: unexpected inputs (n_in %d, ws %zu)\n", n_in, ws_size); grid = -1; return; }
        int dev = 0, cus = 0, per_cu = 0;
        hipGetDevice(&dev); hipDeviceGetAttribute(&cus, hipDeviceAttributeMultiprocessorCount, dev);
        hipFuncSetAttribute((const void*)hybrid_fwd, hipFuncAttributeMaxDynamicSharedMemorySize, LDS_BYTES);
        hipOccupancyMaxActiveBlocksPerMultiprocessor(&per_cu, (const void*)hybrid_fwd, 512, LDS_BYTES);
        (void)hipGetLastError();
        if (per_cu < 1) fprintf(stderr, "kernel_launch: occupancy query says %d blocks per CU\n", per_cu);
        grid = cus;
    }
    if (grid < 0) return;
    Params p{};
    for (int i = 0; i < 31; ++i) p.in[i] = (const float*)d_in[i];
    p.out = (float*)d_out; p.ws = (unsigned char*)d_ws; p.ph_lo = 0; p.ph_hi = 31;
    void* args[] = {&p};
    hipError_t e = hipLaunchCooperativeKernel((const void*)hybrid_fwd, dim3(grid), dim3(512), args, LDS_BYTES, stream);
    if (e != hipSuccess) fprintf(stderr, "cooperative launch failed: %s (grid %d)\n", hipGetErrorString(e), grid);
}
```

```cpp
#include <hip/hip_runtime.h>
#include <hip/hip_cooperative_groups.h>
#include <cstdio>
#include <cstdint>
#include <cmath>
namespace cg = cooperative_groups;

#define LAS __attribute__((address_space(3)))
typedef unsigned short bf16_t;
typedef short bf16x8 __attribute__((ext_vector_type(8)));
typedef short s16x4 __attribute__((ext_vector_type(4)));
typedef float f32x4 __attribute__((ext_vector_type(4)));
typedef float f32x2 __attribute__((ext_vector_type(2)));
typedef float f32x16 __attribute__((ext_vector_type(16)));
typedef unsigned u32x4 __attribute__((ext_vector_type(4)));
typedef unsigned u32x2 __attribute__((ext_vector_type(2)));

constexpr int NB = 8, SEQ = 8192, DM = 1024, MTOK = NB * SEQ, DINP = 2304, FF = 4096, NMEM = 256;
constexpr float LOG2E = 1.4426950408889634f;
constexpr float EPS = 1e-6f;
constexpr float NEGV = -1e30f;

constexpr size_t MiB = 1u << 20;
constexpr size_t WS_W = 1 * MiB, WS_WL = 40 * MiB;
constexpr size_t W_IN = 0, W_OUT = 5 * MiB, W_Q = 7 * MiB, W_O = 9 * MiB, W_1 = 11 * MiB, W_2 = 19 * MiB, W_K = 27 * MiB, W_V = 29 * MiB,
                 W_CK1 = 31 * MiB, W_CV1 = 32 * MiB, W_CK2 = 33 * MiB, W_CV2 = 33 * MiB + 128 * 1024, W_POOL = 33 * MiB + 256 * 1024,
                 W_CPW = 33 * MiB + 384 * 1024, W_CB1K = 33 * MiB + 512 * 1024, W_CB1V = 33 * MiB + 516 * 1024, W_MEMN = 34 * MiB;
constexpr size_t WS_KM = 82 * MiB, WS_VMT = 90 * MiB;
constexpr size_t WS_KCRAW = 100 * MiB, WS_VCRAW = 117 * MiB;
constexpr size_t WS_HIDK = 134 * MiB, WS_HIDV = 138 * MiB, WS_KC = 142 * MiB, WS_VC = 146 * MiB;
constexpr size_t WS_XN = 160 * MiB, WS_MIX = 288 * MiB, WS_BIG = 416 * MiB;
constexpr size_t WS_PROJ = WS_BIG, WS_CAT = 704 * MiB, WS_ACT = 832 * MiB, WS_HID = WS_BIG;
constexpr size_t WS_END = 928 * MiB;

constexpr int LDS_BYTES = 147456;
constexpr int XS_OFF = 131072;

__device__ __forceinline__ unsigned f2bf(float f) { unsigned u = __builtin_bit_cast(unsigned, f); return (u + 0x7fffu + ((u >> 16) & 1u)) >> 16; }
__device__ __forceinline__ unsigned pk2(float lo, float hi) { return f2bf(lo) | (f2bf(hi) << 16); }
__device__ __forceinline__ float bf2f(unsigned short b) { return __builtin_bit_cast(float, (unsigned)b << 16); }
__device__ __forceinline__ unsigned cvt_pk_bf16(float lo, float hi) { unsigned r; asm volatile("v_cvt_pk_bf16_f32 %0, %1, %2" : "=v"(r) : "v"(lo), "v"(hi)); return r; }
__device__ __forceinline__ float wave_sum(float v) {
#pragma unroll
    for (int o = 1; o < 64; o <<= 1) v += __shfl_xor(v, o);
    return v;
}
__device__ __forceinline__ float ex2(float x) { return __builtin_amdgcn_exp2f(x); }
__device__ __forceinline__ int opaque_tid() { int t = threadIdx.x; asm volatile("" : "+v"(t)); return t; }

namespace pg8 {
constexpr int BM = 256, BK = 64, HALF = 128, HTB = HALF * BK * 2, STAGE_BYTES = 8 * HTB, NXCD = 8, WGM = 8;
__host__ __device__ __forceinline__ int lds_byte(int r, int c) { const int st = (r >> 4) * 2 + (c >> 5), rr = r & 15, cc = c & 31, ob = rr * 64 + cc * 2; return st * 1024 + (ob ^ (((ob >> 9) & 1) << 5)); }
__host__ __device__ __forceinline__ void stage_rc(int b, int& R, int& C) { const int st = b / 1024, sb = b % 1024, swz = sb ^ (((sb >> 9) & 1) << 5); R = (st >> 1) * 16 + swz / 64; C = (st & 1) * 32 + (swz % 64) / 2; }
__host__ __device__ __forceinline__ int perm32(int rho) { const int n = rho >> 4, i = rho & 15; return 8 * (i >> 2) + 4 * n + (i & 3); }

struct Unit { int pm, pn; };
struct Gemm {
    const bf16_t* A; const bf16_t* Bt; int lda, ldb, K; size_t a_pn, b_pn, b_batch; int mtpb;
    __device__ __forceinline__ const char* a_ptr(const Unit& u) const { return (const char*)(A + (size_t)u.pm * BM * lda + (size_t)u.pn * a_pn); }
    __device__ __forceinline__ const char* b_ptr(const Unit& u) const { return (const char*)(Bt + (size_t)u.pn * b_pn + (size_t)(u.pm / mtpb) * b_batch); }
};
struct StaticOrder {
    int nM, nN, nwg, G, c;
    __device__ void init(int M, int N, int G_, int c_) { nM = M / BM; nN = N / BM; nwg = nM * nN; G = G_; c = c_; }
    __device__ bool next(int i, Unit& u) const {
        const long L = (long)i * G + c; if (L >= nwg) return false;
        int wgid = (int)L; { const int q = nwg / NXCD, r = nwg % NXCD, xcd = wgid % NXCD, off = wgid / NXCD; wgid = (xcd < r ? xcd * (q + 1) : r * (q + 1) + (xcd - r) * q) + off; }
        const int nig = WGM * nN, gid = wgid / nig, fm = gid * WGM, gsz = (nM - fm) < WGM ? (nM - fm) : WGM;
        u.pm = fm + ((wgid % nig) % gsz); u.pn = (wgid % nig) / gsz; return true;
    }
};

struct Epi {
    bf16_t* O; int ldc; const float* bias; int act; int sc_lo, sc_hi; float sc;
    __device__ __forceinline__ void operator()(f32x4 (&acc)[2][2][4][2], const Unit& u, int wr, int wc, int fr, int fq, LAS unsigned char* xs) const {
        const int row0 = u.pm * BM + wr * 64 + fr; const int col0 = u.pn * BM + wc * 32 + 8 * fq;
        const float s = (u.pn >= sc_lo && u.pn < sc_hi) ? sc : 1.f;
        if (act == 3) {
            LAS f32x2* XS = (LAS f32x2*)xs;
            float mloc[2][4];
#pragma unroll
            for (int ai = 0; ai < 2; ++ai)
#pragma unroll
                for (int m = 0; m < 4; ++m) {
                    float mx = NEGV;
#pragma unroll
                    for (int bj = 0; bj < 2; ++bj)
#pragma unroll
                        for (int n = 0; n < 2; ++n) { const f32x4 x = acc[ai][bj][m][n]; mx = fmaxf(mx, fmaxf(fmaxf(x[0], x[1]), fmaxf(x[2], x[3]))); }
                    mx = fmaxf(mx, __shfl_xor(mx, 16)); mx = fmaxf(mx, __shfl_xor(mx, 32));
                    float sm = 0.f;
#pragma unroll
                    for (int bj = 0; bj < 2; ++bj)
#pragma unroll
                        for (int n = 0; n < 2; ++n) { f32x4 x = acc[ai][bj][m][n]; x[0] = ex2(x[0] - mx); x[1] = ex2(x[1] - mx); x[2] = ex2(x[2] - mx); x[3] = ex2(x[3] - mx); acc[ai][bj][m][n] = x; sm += (x[0] + x[1]) + (x[2] + x[3]); }
                    sm += __shfl_xor(sm, 16); sm += __shfl_xor(sm, 32);
                    mloc[ai][m] = mx;
                    if (fq == 0) XS[(ai * HALF + wr * 64 + m * 16 + fr) * 4 + wc] = (f32x2){mx, sm};
                }
            asm volatile("s_waitcnt lgkmcnt(0)" ::: "memory"); __builtin_amdgcn_s_barrier(); asm volatile("" ::: "memory");
#pragma unroll
            for (int ai = 0; ai < 2; ++ai)
#pragma unroll
                for (int m = 0; m < 4; ++m) {
                    const int r = ai * HALF + wr * 64 + m * 16 + fr;
                    const f32x2 a = XS[r * 4 + 0], b = XS[r * 4 + 1], c = XS[r * 4 + 2], d = XS[r * 4 + 3];
                    const float mt = fmaxf(fmaxf(a.x, b.x), fmaxf(c.x, d.x));
                    const float l = a.y * ex2(a.x - mt) + b.y * ex2(b.x - mt) + c.y * ex2(c.x - mt) + d.y * ex2(d.x - mt);
                    const float f = ex2(mloc[ai][m] - mt) / l;
                    bf16_t* rowp = O + (size_t)(row0 + ai * HALF + m * 16) * ldc + col0;
#pragma unroll
                    for (int bj = 0; bj < 2; ++bj) { const f32x4 v0 = acc[ai][bj][m][0] * f, v1 = acc[ai][bj][m][1] * f;
                        u32x4 w; w.x = cvt_pk_bf16(v0[0], v0[1]); w.y = cvt_pk_bf16(v0[2], v0[3]); w.z = cvt_pk_bf16(v1[0], v1[1]); w.w = cvt_pk_bf16(v1[2], v1[3]);
                        *(u32x4*)(rowp + bj * HALF) = w; }
                }
            return;
        }
        f32x4 bv[2][2];
#pragma unroll
        for (int bj = 0; bj < 2; ++bj)
#pragma unroll
            for (int n = 0; n < 2; ++n) bv[bj][n] = bias ? *(const f32x4*)(bias + col0 + bj * HALF + 4 * n) : (f32x4){0.f, 0.f, 0.f, 0.f};
#pragma unroll
        for (int ai = 0; ai < 2; ++ai)
#pragma unroll
            for (int m = 0; m < 4; ++m) { bf16_t* rowp = O + (size_t)(row0 + ai * HALF + m * 16) * ldc + col0;
#pragma unroll
                for (int bj = 0; bj < 2; ++bj) { f32x4 v0 = acc[ai][bj][m][0] + bv[bj][0], v1 = acc[ai][bj][m][1] + bv[bj][1];
                    if (act == 1) {
#pragma unroll
                        for (int e = 0; e < 4; ++e) { float a = fmaxf(v0[e], 0.f), b = fmaxf(v1[e], 0.f); v0[e] = a * a; v1[e] = b * b; }
                    } else if (act == 2) {
#pragma unroll
                        for (int e = 0; e < 4; ++e) { float a = v0[e], b = v1[e];
                            float ua = 1.5957691216f * (a + 0.044715f * a * a * a), ub = 1.5957691216f * (b + 0.044715f * b * b * b);
                            v0[e] = a / (1.f + __expf(-ua)); v1[e] = b / (1.f + __expf(-ub)); }
                    }
                    v0 = v0 * s; v1 = v1 * s; u32x4 w; w.x = cvt_pk_bf16(v0[0], v0[1]); w.y = cvt_pk_bf16(v0[2], v0[3]); w.z = cvt_pk_bf16(v1[0], v1[1]); w.w = cvt_pk_bf16(v1[2], v1[3]);
                    *(u32x4*)(rowp + bj * HALF) = w; } }
    }
};

__device__ __forceinline__ void gemm_phase(LAS unsigned char* lds, const Gemm g, const StaticOrder& S, const Epi& E) {
    const int tid = opaque_tid(), wid = __builtin_amdgcn_readfirstlane(tid >> 6), lane = tid & 63, wr = wid >> 2, wc = wid & 3, fr = lane & 15, fq = lane >> 4;
    const int K = g.K, nt = K / BK;
    unsigned voffA[2], voffB[2];
#pragma unroll
    for (int i = 0; i < 2; ++i) { int R, C; stage_rc(tid * 16 + i * 8192, R, C); const int Rb = (R & ~31) + perm32(R & 31);
        voffA[i] = (unsigned)(R * g.lda + C) * 2u; voffB[i] = (unsigned)(Rb * g.ldb + C) * 2u; }
    const size_t kstep = (size_t)(BK * 2);
    const size_t hA = (size_t)HALF * g.lda * 2, hB = (size_t)HALF * g.ldb * 2;
    const unsigned ldsw = (unsigned)wid * 1024u;
    const int aoff = lds_byte(wr * 64 + fr, fq * 8), boff = lds_byte(wc * 32 + fr, fq * 8);
#define PG8_SA(b, h) (((b) * 2 + (h)) * HTB)
#define PG8_SB(b, h) ((4 + (b) * 2 + (h)) * HTB)
#define PG8_STAGE(bufoff, gbase, voff) do { _Pragma("unroll") for (int _i = 0; _i < 2; ++_i) \
        __builtin_amdgcn_global_load_lds((const unsigned*)((const char*)(gbase) + (voff)[_i]), (LAS unsigned*)(lds + (bufoff) + ldsw + _i * 8192), 16, 0, 0); } while (0)
#define PG8_LDA(dst, b, h) do { _Pragma("unroll") for (int m = 0; m < 4; ++m) _Pragma("unroll") for (int k = 0; k < 2; ++k) dst[m][k] = *(const LAS bf16x8*)(lds + PG8_SA(b, h) + aoff + m * 2048 + k * 1024); } while (0)
#define PG8_LDB(dst, b, h) do { _Pragma("unroll") for (int n = 0; n < 2; ++n) _Pragma("unroll") for (int k = 0; k < 2; ++k) dst[n][k] = *(const LAS bf16x8*)(lds + PG8_SB(b, h) + boff + n * 2048 + k * 1024); } while (0)
#define PG8_MMA(ai, bj, At, Bt) do { __builtin_amdgcn_s_setprio(1); _Pragma("unroll") for (int m = 0; m < 4; ++m) _Pragma("unroll") for (int n = 0; n < 2; ++n) _Pragma("unroll") for (int k = 0; k < 2; ++k) \
        acc[ai][bj][m][n] = __builtin_amdgcn_mfma_f32_16x16x32_bf16(Bt[n][k], At[m][k], acc[ai][bj][m][n], 0, 0, 0); __builtin_amdgcn_s_setprio(0); } while (0)
#define PG8_WAIT_V(n) asm volatile("s_waitcnt vmcnt(" #n ")" ::: "memory")
#define PG8_WAIT_L(n) asm volatile("s_waitcnt lgkmcnt(" #n ")" ::: "memory")
#define PG8_BAR __builtin_amdgcn_s_barrier()
#define PG8_SCHED __builtin_amdgcn_sched_barrier(0)
    Unit cur, nxt; int ui = 0;
    if (!S.next(0, cur)) return;
    f32x4 acc[2][2][4][2];
#pragma unroll
    for (int a = 0; a < 2; ++a)
#pragma unroll
        for (int b = 0; b < 2; ++b)
#pragma unroll
            for (int m = 0; m < 4; ++m)
#pragma unroll
                for (int n = 0; n < 2; ++n) acc[a][b][m][n] = (f32x4){0.f, 0.f, 0.f, 0.f};
    bf16x8 At[4][2], B0[2][2], B1[2][2];
    const char* cA = g.a_ptr(cur); const char* cB = g.b_ptr(cur);
    PG8_STAGE(PG8_SB(0, 0), cB, voffB); PG8_STAGE(PG8_SB(0, 1), cB + hB, voffB); PG8_STAGE(PG8_SA(0, 0), cA, voffA); PG8_STAGE(PG8_SA(0, 1), cA + hA, voffA);
    if (wr == 1) PG8_BAR;
    PG8_WAIT_V(2); PG8_BAR;
    PG8_STAGE(PG8_SB(1, 0), cB + kstep, voffB); PG8_STAGE(PG8_SA(1, 0), cA + kstep, voffA); PG8_STAGE(PG8_SB(1, 1), cB + hB + kstep, voffB);
    PG8_WAIT_V(6); PG8_BAR;
    for (;;) {
        const bool has_next = S.next(ui + 1, nxt);
        const char* nA = has_next ? g.a_ptr(nxt) : cA; const char* nB = has_next ? g.b_ptr(nxt) : cB;
        for (int t = 0; t < nt; t += 2) {
            const bool last = (t == nt - 2);
            const char* a1 = cA + (size_t)(t + 1) * kstep;
            const char* a2 = last ? nA : cA + (size_t)(t + 2) * kstep; const char* b2 = last ? nB : cB + (size_t)(t + 2) * kstep;
            const char* a3 = a2 + kstep; const char* b3 = b2 + kstep;
            PG8_LDB(B0, 0, 0); PG8_LDB(B1, 0, 1); PG8_SCHED; PG8_LDA(At, 0, 0); PG8_STAGE(PG8_SA(1, 1), a1 + hA, voffA);
            PG8_WAIT_V(8); PG8_WAIT_L(0); PG8_BAR; PG8_MMA(0, 0, At, B0); PG8_MMA(0, 1, At, B1); PG8_BAR; PG8_SCHED;
            PG8_LDA(At, 0, 1); PG8_STAGE(PG8_SB(0, 0), b2, voffB); PG8_STAGE(PG8_SB(0, 1), b2 + hB, voffB); PG8_STAGE(PG8_SA(0, 0), a2, voffA);
            PG8_WAIT_V(8); PG8_WAIT_L(0); PG8_BAR; PG8_MMA(1, 0, At, B0); PG8_MMA(1, 1, At, B1); PG8_BAR; PG8_SCHED;
            PG8_LDB(B0, 1, 0); PG8_LDB(B1, 1, 1); PG8_SCHED; PG8_LDA(At, 1, 0); PG8_STAGE(PG8_SA(0, 1), a2 + hA, voffA);
            PG8_WAIT_V(8); PG8_WAIT_L(0); PG8_BAR; PG8_MMA(0, 0, At, B0); PG8_MMA(0, 1, At, B1); PG8_BAR; PG8_SCHED;
            PG8_LDA(At, 1, 1); PG8_STAGE(PG8_SB(1, 0), b3, voffB); PG8_STAGE(PG8_SB(1, 1), b3 + hB, voffB); PG8_STAGE(PG8_SA(1, 0), a3, voffA);
            PG8_WAIT_V(8); PG8_WAIT_L(0); PG8_BAR; PG8_MMA(1, 0, At, B0); PG8_MMA(1, 1, At, B1); PG8_BAR; PG8_SCHED;
        }
        if (wr == 0) PG8_BAR;
        E(acc, cur, wr, wc, fr, fq, lds + XS_OFF);
        if (!has_next) break;
#pragma unroll
        for (int a = 0; a < 2; ++a)
#pragma unroll
            for (int b = 0; b < 2; ++b)
#pragma unroll
                for (int m = 0; m < 4; ++m)
#pragma unroll
                    for (int n = 0; n < 2; ++n) acc[a][b][m][n] = (f32x4){0.f, 0.f, 0.f, 0.f};
        cur = nxt; cA = nA; cB = nB; ++ui;
        if (wr == 1) PG8_BAR;
    }
    PG8_WAIT_V(0);
    PG8_BAR;
#undef PG8_SA
#undef PG8_SB
#undef PG8_STAGE
#undef PG8_LDA
#undef PG8_LDB
#undef PG8_MMA
#undef PG8_WAIT_V
#undef PG8_WAIT_L
#undef PG8_BAR
#undef PG8_SCHED
}
}

struct Params {
    const float* in[31];
    float* out;
    unsigned char* ws;
    int ph_lo, ph_hi;
};
enum { I_X = 0, I_MEM, I_RELB, I_MIXPRE, I_MIXPOST, I_WIN, I_POOLW, I_POOLS, I_CONVW, I_CONVB, I_CLNG, I_CLNB, I_CPW, I_CKPOS, I_CKW1, I_CKW2,
       I_CVPOS, I_CVW1, I_CVW2, I_WOUT, I_XAPRE, I_XAPOST, I_MEMG, I_WQ, I_WK, I_WV, I_WO, I_MLPPRE, I_MLPPOST, I_W1, I_W2 };

__device__ __forceinline__ void tr_item(const float* W, int K, int N, int Npad, bf16_t* WT, LAS float* scr, int item, int lane) {
    const int nblk = Npad / 32, kb = item / nblk, nb = item % nblk, k0 = 64 * kb, n0 = 32 * nb;
    const int nn = n0 + (lane & 31);
#pragma unroll 8
    for (int i = 0; i < 32; ++i) { const int kk = 2 * i + (lane >> 5); scr[kk * 33 + (lane & 31)] = (nn < N) ? W[(size_t)(k0 + kk) * N + nn] : 0.f; }
    asm volatile("s_waitcnt lgkmcnt(0)" ::: "memory");
    const int c = lane & 7;
#pragma unroll
    for (int j = 0; j < 4; ++j) { const int n = (lane >> 3) + 8 * j; const LAS float* s = scr + (8 * c) * 33 + n;
        u32x4 o; o.x = pk2(s[0 * 33], s[1 * 33]); o.y = pk2(s[2 * 33], s[3 * 33]); o.z = pk2(s[4 * 33], s[5 * 33]); o.w = pk2(s[6 * 33], s[7 * 33]);
        *(u32x4*)(WT + (size_t)(n0 + n) * K + k0 + 8 * c) = o; }
    asm volatile("s_waitcnt lgkmcnt(0)" ::: "memory");
}
__device__ __forceinline__ void rms_row_to_bf16(const float* xrow, const float* g, bf16_t* orow, int lane) {
    const f32x4* xr = (const f32x4*)xrow + lane; const f32x4* gr = (const f32x4*)g + lane;
    f32x4 v[4]; float s = 0.f;
#pragma unroll
    for (int j = 0; j < 4; ++j) { v[j] = xr[64 * j]; s += (v[j].x * v[j].x + v[j].y * v[j].y) + (v[j].z * v[j].z + v[j].w * v[j].w); }
    const float rstd = 1.f / sqrtf(wave_sum(s) * (1.f / DM) + EPS);
    u32x2* o8 = (u32x2*)orow + lane;
#pragma unroll
    for (int j = 0; j < 4; ++j) { const f32x4 gg = gr[64 * j]; u32x2 w; w.x = pk2(v[j].x * rstd * gg.x, v[j].y * rstd * gg.y); w.y = pk2(v[j].z * rstd * gg.z, v[j].w * rstd * gg.w); o8[64 * j] = w; }
}

__device__ __forceinline__ void prologue_phase(const Params& p, LAS unsigned char* lds, int vcu, int G) {
    const int tid = opaque_tid(), lane = tid & 63, wave = tid >> 6;
    LAS float* scr = (LAS float*)(lds + wave * 16384);
    const int gw = vcu * 8 + wave, NGW = G * 8;
    unsigned char* ws = p.ws;
    constexpr int I_IN = 16 * 72, I_SQ = 16 * 32, I_1 = 16 * 128, I_2 = 64 * 32, I_C1 = 32 * 8, I_C2 = 4 * 8, I_PW = 4 * 8;
    constexpr int PER_L = I_IN + 5 * I_SQ + I_1 + I_2 + 2 * I_C1 + 2 * I_C2 + I_PW;
    for (int it = gw; it < 2 * PER_L; it += NGW) {
        const int l = it / PER_L; int r = it % PER_L; unsigned char* wl = ws + WS_W + (size_t)l * WS_WL;
        if (r < I_IN) { tr_item(p.in[I_WIN] + (size_t)l * DM * 2072, DM, 2072, DINP, (bf16_t*)(wl + W_IN), scr, r, lane); continue; } r -= I_IN;
        if (r < I_SQ) { tr_item(p.in[I_WOUT] + (size_t)l * DM * DM, DM, DM, DM, (bf16_t*)(wl + W_OUT), scr, r, lane); continue; } r -= I_SQ;
        if (r < I_SQ) { tr_item(p.in[I_WQ] + (size_t)l * DM * DM, DM, DM, DM, (bf16_t*)(wl + W_Q), scr, r, lane); continue; } r -= I_SQ;
        if (r < I_SQ) { tr_item(p.in[I_WO] + (size_t)l * DM * DM, DM, DM, DM, (bf16_t*)(wl + W_O), scr, r, lane); continue; } r -= I_SQ;
        if (r < I_SQ) { tr_item(p.in[I_WK] + (size_t)l * DM * DM, DM, DM, DM, (bf16_t*)(wl + W_K), scr, r, lane); continue; } r -= I_SQ;
        if (r < I_SQ) { tr_item(p.in[I_WV] + (size_t)l * DM * DM, DM, DM, DM, (bf16_t*)(wl + W_V), scr, r, lane); continue; } r -= I_SQ;
        if (r < I_1) { tr_item(p.in[I_W1] + (size_t)l * DM * FF, DM, FF, FF, (bf16_t*)(wl + W_1), scr, r, lane); continue; } r -= I_1;
        if (r < I_2) { tr_item(p.in[I_W2] + (size_t)l * FF * DM, FF, DM, DM, (bf16_t*)(wl + W_2), scr, r, lane); continue; } r -= I_2;
        if (r < I_C1) { tr_item(p.in[I_CKW1] + (size_t)l * 2048 * 256, 2048, 256, 256, (bf16_t*)(wl + W_CK1), scr, r, lane); continue; } r -= I_C1;
        if (r < I_C1) { tr_item(p.in[I_CVW1] + (size_t)l * 2048 * 256, 2048, 256, 256, (bf16_t*)(wl + W_CV1), scr, r, lane); continue; } r -= I_C1;
        if (r < I_C2) { tr_item(p.in[I_CKW2] + (size_t)l * 256 * 64, 256, 64, 256, (bf16_t*)(wl + W_CK2), scr, r, lane); continue; } r -= I_C2;
        if (r < I_C2) { tr_item(p.in[I_CVW2] + (size_t)l * 256 * 64, 256, 64, 256, (bf16_t*)(wl + W_CV2), scr, r, lane); continue; } r -= I_C2;
        tr_item(p.in[I_CPW] + (size_t)l * 256 * 256, 256, 256, 256, (bf16_t*)(wl + W_CPW), scr, r, lane);
    }
    for (int e = vcu * 512 + tid; e < 2 * 65536; e += G * 512) {
        const int l = e >> 16, n = (e >> 8) & 255, k = e & 255;
        float v = 0.f;
        if ((n >> 6) == (k >> 6)) v = p.in[I_POOLW][(size_t)l * 16384 + (n >> 6) * 4096 + (k & 63) * 64 + (n & 63)] * p.in[I_POOLS][l * 256 + n];
        ((bf16_t*)(ws + WS_W + (size_t)l * WS_WL + W_POOL))[n * 256 + k] = (bf16_t)f2bf(v);
    }
    for (int it = vcu; it < 16; it += G) {
        const int l = it >> 3, kv = (it >> 2) & 1, nc = it & 3;
        const float* pos = p.in[kv ? I_CVPOS : I_CKPOS] + (size_t)l * 2048;
        const float* w1 = p.in[kv ? I_CVW1 : I_CKW1] + (size_t)l * 2048 * 256;
        const int ks = tid >> 6, n = nc * 64 + (tid & 63);
        float a = 0.f;
        for (int k = ks * 256; k < ks * 256 + 256; ++k) a += pos[k] * w1[(size_t)k * 256 + n];
        LAS float* red = (LAS float*)(lds + 131072);
        red[ks * 64 + (tid & 63)] = a;
        __syncthreads();
        if (tid < 64) { float s = 0.f;
#pragma unroll
            for (int q = 0; q < 8; ++q) s += red[q * 64 + tid];
            ((float*)(ws + WS_W + (size_t)l * WS_WL + (kv ? W_CB1V : W_CB1K)))[nc * 64 + tid] = s; }
        __syncthreads();
    }
    for (int m = gw; m < 2 * NB * NMEM; m += NGW) { const int l = m / (NB * NMEM), r = m % (NB * NMEM);
        rms_row_to_bf16(p.in[I_MEM] + (size_t)r * DM, p.in[I_MEMG] + l * DM, (bf16_t*)(ws + WS_W + (size_t)l * WS_WL + W_MEMN) + (size_t)r * DM, lane); }
    for (int m = gw; m < MTOK; m += NGW) rms_row_to_bf16(p.in[I_X] + (size_t)m * DM, p.in[I_MIXPRE], (bf16_t*)(ws + WS_XN) + (size_t)m * DM, lane);
}

__device__ __forceinline__ void rowwise_phase(const float* xsrc, float* xdst, const bf16_t* mix, const float* gpost, const float* gnext, bf16_t* xn, int vcu, int G) {
    const int tid = opaque_tid(), lane = tid & 63, wave = tid >> 6;
    const int gw = vcu * 8 + wave, NGW = G * 8;
    for (int m = gw; m < MTOK; m += NGW) {
        const f32x4* xr = (const f32x4*)(xsrc + (size_t)m * DM) + lane; const u32x2* mr = (const u32x2*)(mix + (size_t)m * DM) + lane;
        f32x4 y[4], x[4]; float s = 0.f;
#pragma unroll
        for (int j = 0; j < 4; ++j) { const u32x2 w = mr[64 * j]; x[j] = xr[64 * j];
            y[j].x = __builtin_bit_cast(float, w.x << 16); y[j].y = __builtin_bit_cast(float, w.x & 0xffff0000u); y[j].z = __builtin_bit_cast(float, w.y << 16); y[j].w = __builtin_bit_cast(float, w.y & 0xffff0000u);
            s += (y[j].x * y[j].x + y[j].y * y[j].y) + (y[j].z * y[j].z + y[j].w * y[j].w); }
        const float rstd = 1.f / sqrtf(wave_sum(s) * (1.f / DM) + EPS);
        float s2 = 0.f;
#pragma unroll
        for (int j = 0; j < 4; ++j) { const f32x4 gg = ((const f32x4*)gpost)[lane + 64 * j]; x[j] = x[j] + y[j] * rstd * gg;
            s2 += (x[j].x * x[j].x + x[j].y * x[j].y) + (x[j].z * x[j].z + x[j].w * x[j].w);
            ((f32x4*)(xdst + (size_t)m * DM))[lane + 64 * j] = x[j]; }
        if (gnext) {
            const float r2 = 1.f / sqrtf(wave_sum(s2) * (1.f / DM) + EPS);
            u32x2* o8 = (u32x2*)(xn + (size_t)m * DM) + lane;
#pragma unroll
            for (int j = 0; j < 4; ++j) { const f32x4 gg = ((const f32x4*)gnext)[lane + 64 * j]; u32x2 w; w.x = pk2(x[j].x * r2 * gg.x, x[j].y * r2 * gg.y); w.y = pk2(x[j].z * r2 * gg.z, x[j].w * r2 * gg.w); o8[64 * j] = w; }
        }
    }
}

__device__ __forceinline__ void prep_phase(const Params& p, int l, LAS unsigned char* lds, int vcu, int G) {
    const int tid = opaque_tid(), lane = tid & 63, wave = tid >> 6;
    const bf16_t* PROJ = (const bf16_t*)(p.ws + WS_PROJ); bf16_t* ACT = (bf16_t*)(p.ws + WS_ACT);
    bf16_t* KCR = (bf16_t*)(p.ws + WS_KCRAW); bf16_t* VCR = (bf16_t*)(p.ws + WS_VCRAW);
    LAS bf16_t* hT = (LAS bf16_t*)lds;
    LAS float* cv = (LAS float*)(lds + 49152);
    const float* cw = p.in[I_CONVW] + (size_t)l * 31 * 256; const float* cb = p.in[I_CONVB] + l * 256;
    const float* lg = p.in[I_CLNG] + l * 256; const float* lb = p.in[I_CLNB] + l * 256;
    for (int u = vcu; u < MTOK / 64; u += G) {
        const int b = u >> 7, t0 = (u & 127) * 64; const size_t R0 = (size_t)b * SEQ + t0;
        for (int it = tid; it < 94 * 32; it += 512) { const int jr = it >> 5, ch = (it & 31) * 8; const int t = t0 - 30 + jr;
            u32x4 o = (u32x4){0u, 0u, 0u, 0u};
            if (t >= 0) { const bf16_t* rp = PROJ + ((size_t)b * SEQ + t) * DINP; const u32x4 a = *(const u32x4*)(rp + 256 + ch), gt = *(const u32x4*)(rp + 512 + ch);
#pragma unroll
                for (int e = 0; e < 4; ++e) { const unsigned aw = a[e], gw_ = gt[e];
                    const float a0 = __builtin_bit_cast(float, aw << 16), a1 = __builtin_bit_cast(float, aw & 0xffff0000u), g0 = __builtin_bit_cast(float, gw_ << 16), g1 = __builtin_bit_cast(float, gw_ & 0xffff0000u);
                    o[e] = pk2(a0 / (1.f + __expf(-g0)), a1 / (1.f + __expf(-g1))); } }
            *(LAS u32x4*)(hT + jr * 256 + ch) = o; }
        { const int c = tid & 255, half = tid >> 8; const int w = 2 << (c >> 6);
          const bf16_t* up = PROJ + (size_t)b * SEQ * DINP + c;
          float sum = 0.f; const int ts = t0 + half * 32;
          for (int d = 1; d < w; ++d) { const int t = ts - d; if (t >= 0) sum += bf2f(up[(size_t)t * DINP]); }
          for (int i = 0; i < 32; ++i) { const int t = ts + i; const float ut = bf2f(up[(size_t)t * DINP]); sum += ut;
              const int cnt = (t + 1 < w) ? (t + 1) : w; const float d = sum / (float)cnt - ut;
              ACT[((size_t)b * SEQ + t) * 512 + c] = (bf16_t)f2bf(d);
              const int tb = t - w + 1; if (tb >= 0) sum -= bf2f(up[(size_t)tb * DINP]); } }
        for (int it = tid; it < 64 * 32; it += 512) { const int i = it >> 5, cc = it & 31; const int which = cc >> 4, g = (cc >> 3) & 1, d8 = (cc & 7) * 8;
            const u32x4 v = *(const u32x4*)(PROJ + (R0 + i) * DINP + 1280 + cc * 8);
            bf16_t* dst = (which ? VCR : KCR) + (((size_t)(b * 2 + g) * SEQ + t0 + i) * 64 + d8); *(u32x4*)dst = v; }
        __syncthreads();
        { const int c = tid & 255, half = tid >> 8; float wv[31];
#pragma unroll
          for (int k = 0; k < 31; ++k) wv[k] = cw[k * 256 + c];
          const float bias = cb[c];
          for (int i = half * 32; i < half * 32 + 32; ++i) { float a = bias;
#pragma unroll
              for (int k = 0; k < 31; ++k) a += wv[k] * bf2f(hT[(i + k) * 256 + c]);
              cv[i * 256 + c] = a; } }
        __syncthreads();
        for (int i = wave * 8; i < wave * 8 + 8; ++i) { const f32x4 x = *(LAS f32x4*)(cv + i * 256 + lane * 4);
            const float mu = wave_sum((x.x + x.y) + (x.z + x.w)) * (1.f / 256.f);
            const f32x4 dd = x - mu; const float var = wave_sum((dd.x * dd.x + dd.y * dd.y) + (dd.z * dd.z + dd.w * dd.w)) * (1.f / 256.f);
            const float rs = 1.f / sqrtf(var + EPS); const f32x4 gg = *(const f32x4*)(lg + lane * 4), bb = *(const f32x4*)(lb + lane * 4);
            f32x4 y = dd * rs * gg + bb;
#pragma unroll
            for (int e = 0; e < 4; ++e) y[e] = y[e] / (1.f + __expf(-y[e]));
            u32x2 w; w.x = pk2(y.x, y.y); w.y = pk2(y.z, y.w);
            *(u32x2*)(ACT + (R0 + i) * 512 + 256 + lane * 4) = w; }
        __syncthreads();
    }
}

namespace nsa {
constexpr int KB0 = 0, VB0 = 16384, LUT_OFF = 32768, WSF_OFF = 35840, SEL_OFF = 36864, IMP_OFF = 38912, OST_OFF = 72192, IMP_PITCH = 129, LUT_PITCH = 132;
__device__ __forceinline__ int crow(int r, int hi) { return (r & 3) + 8 * (r >> 2) + 4 * hi; }
__device__ __forceinline__ int rel_bucket_dev(int n) {
    if (n < 16) return n;
    const float v = logf((float)n / 16.f) / 2.0794415416798357f * 16.f;
    const int b = 16 + (int)v; return b < 31 ? b : 31;
}
__device__ __forceinline__ s16x4 vtr(LAS const char* p) { return __builtin_bit_cast(s16x4, __builtin_amdgcn_ds_read_tr16_b64_v4i16((LAS s16x4*)p)); }

struct TileRegs { u32x4 k, v; };
__device__ __forceinline__ void gload(TileRegs& R, const bf16_t* Kg, const bf16_t* Vg, int pitch, int tile, int wid, int lane) {
    R.k = *(const u32x4*)(Kg + (size_t)(tile * 64 + lane) * pitch + wid * 8);
    R.v = *(const u32x4*)(Vg + (size_t)(tile * 64 + 16 * (wid & 3) + (lane >> 2)) * pitch + (wid >> 2) * 32 + (lane & 3) * 8);
}
__device__ __forceinline__ void lstore(const TileRegs& R, LAS unsigned char* lds, int buf, int wid, int lane) {
    *(LAS u32x4*)(lds + KB0 + buf * 8192 + wid * 1024 + lane * 16) = R.k;
    *(LAS u32x4*)(lds + VB0 + buf * 8192 + wid * 1024 + lane * 16) = R.v;
}

template <int BR>
__device__ __forceinline__ void tile_compute(LAS unsigned char* lds, int buf, const bf16x8 (&qr)[4], f32x16 (&o)[2], float& m, float& l, float linv,
                                             int Dbase, bool general, float farb, LAS const float* lutr, bool rowvalid, int tok, int mbase, float& carry, int lane, int wid) {
    const int r32 = lane & 31, hi = lane >> 5;
    constexpr int KS = (BR <= 1) ? 16 : 1;
    f32x16 p0 = {}, p1 = {};
    { LAS const char* kb = (LAS const char*)(lds + KB0 + buf * 8192 + hi * 1024 + r32 * 16);
#pragma unroll
      for (int d0 = 0; d0 < 4; ++d0) { const bf16x8 b0 = *(LAS const bf16x8*)(kb + d0 * 2048), b1 = *(LAS const bf16x8*)(kb + d0 * 2048 + 512);
          p0 = __builtin_amdgcn_mfma_f32_32x32x16_bf16(b0, qr[d0], p0, 0, 0, 0); p1 = __builtin_amdgcn_mfma_f32_32x32x16_bf16(b1, qr[d0], p1, 0, 0, 0); } }
    if (general) {
#pragma unroll
        for (int r = 0; r < 16; ++r) { const int kv = crow(r, hi); const int d0 = Dbase - KS * kv, d1 = d0 - KS * 32;
            bool v0 = d0 >= 0 && rowvalid, v1 = d1 >= 0 && rowvalid; if (BR == 3) { v0 = v0 && d0 < 512; v1 = v1 && d1 < 512; }
            const int i0 = d0 < 0 ? 0 : (d0 > 128 ? 128 : d0), i1 = d1 < 0 ? 0 : (d1 > 128 ? 128 : d1);
            p0[r] = v0 ? p0[r] + lutr[i0] : NEGV; p1[r] = v1 ? p1[r] + lutr[i1] : NEGV; }
    } else {
#pragma unroll
        for (int r = 0; r < 16; ++r) { p0[r] = rowvalid ? p0[r] + farb : NEGV; p1[r] = rowvalid ? p1[r] + farb : NEGV; }
    }
    if (BR == 1) {
#pragma unroll
        for (int r = 0; r < 16; ++r) { p0[r] = ex2(p0[r] - m) * linv; p1[r] = ex2(p1[r] - m) * linv; }
        LAS float* IMP = (LAS float*)(lds + IMP_OFF) + tok * IMP_PITCH;
        float px[4], py[4];
#pragma unroll
        for (int k = 0; k < 4; ++k) { px[k] = __shfl_xor(p0[4 * k + 3], 32); py[k] = __shfl_xor(p1[4 * k + 3], 32); }
#pragma unroll
        for (int k = 0; k < 4; ++k) {
            const float pv0 = hi ? px[k] : (k == 0 ? carry : px[k > 0 ? k - 1 : 0]);
            const float pv1 = hi ? py[k] : (k == 0 ? px[3] : py[k > 0 ? k - 1 : 0]);
            float g0 = (p0[4 * k] + p0[4 * k + 1]) + (p0[4 * k + 2] + p0[4 * k + 3]) + pv0;
            float g1 = (p1[4 * k] + p1[4 * k + 1]) + (p1[4 * k + 2] + p1[4 * k + 3]) + pv1;
            g0 += __shfl_xor(g0, 1); g0 += __shfl_xor(g0, 2); g1 += __shfl_xor(g1, 1); g1 += __shfl_xor(g1, 2);
            if ((r32 & 3) == 0) { const int mi = mbase + 2 * k + hi; IMP[mi] = g0; IMP[mi + 8] = g1; }
        }
        carry = py[3];
    } else {
        float mx = NEGV;
#pragma unroll
        for (int r = 0; r < 16; ++r) mx = fmaxf(mx, fmaxf(p0[r], p1[r]));
        mx = fmaxf(mx, __shfl_xor(mx, 32));
        const float mn = fmaxf(m, mx); const float alpha = ex2(m - mn); m = mn;
        float sm = 0.f;
#pragma unroll
        for (int r = 0; r < 16; ++r) { p0[r] = ex2(p0[r] - mn); p1[r] = ex2(p1[r] - mn); sm += p0[r] + p1[r]; }
        l = l * alpha + sm;
        if (BR >= 2) {
            if (__any(alpha != 1.f)) {
                LAS float* wsf = (LAS float*)(lds + WSF_OFF) + wid * 32;
                if (hi == 0) wsf[r32] = alpha;
                asm volatile("s_waitcnt lgkmcnt(0)" ::: "memory");
#pragma unroll
                for (int r = 0; r < 16; ++r) { const float a = wsf[crow(r, hi)]; o[0][r] *= a; o[1][r] *= a; }
                asm volatile("s_waitcnt lgkmcnt(0)" ::: "memory");
            }
        }
    }
    if (BR >= 1) {
        u32x4 pw[4];
        pw[0] = (u32x4){cvt_pk_bf16(p0[0], p0[1]), cvt_pk_bf16(p0[2], p0[3]), cvt_pk_bf16(p0[4], p0[5]), cvt_pk_bf16(p0[6], p0[7])};
        pw[1] = (u32x4){cvt_pk_bf16(p0[8], p0[9]), cvt_pk_bf16(p0[10], p0[11]), cvt_pk_bf16(p0[12], p0[13]), cvt_pk_bf16(p0[14], p0[15])};
        pw[2] = (u32x4){cvt_pk_bf16(p1[0], p1[1]), cvt_pk_bf16(p1[2], p1[3]), cvt_pk_bf16(p1[4], p1[5]), cvt_pk_bf16(p1[6], p1[7])};
        pw[3] = (u32x4){cvt_pk_bf16(p1[8], p1[9]), cvt_pk_bf16(p1[10], p1[11]), cvt_pk_bf16(p1[12], p1[13]), cvt_pk_bf16(p1[14], p1[15])};
        LAS const char* vp = (LAS const char*)(lds + VB0 + buf * 8192 + ((lane >> 4) & 1) * 32 + (lane & 3) * 8 + (4 * hi + ((lane & 15) >> 2)) * 64);
#pragma unroll
        for (int d0 = 0; d0 < 2; ++d0)
#pragma unroll
            for (int ks = 0; ks < 4; ++ks) { const s16x4 lo = vtr(vp + d0 * 4096 + ks * 1024), hh = vtr(vp + d0 * 4096 + ks * 1024 + 512);
                const bf16x8 vf = (bf16x8){lo[0], lo[1], lo[2], lo[3], hh[0], hh[1], hh[2], hh[3]};
                o[d0] = __builtin_amdgcn_mfma_f32_32x32x16_bf16(__builtin_bit_cast(bf16x8, pw[ks]), vf, o[d0], 0, 0, 0); }
    }
}

__device__ __forceinline__ void accum_branch(LAS unsigned char* lds, f32x16 (&o)[2], float fac, bool first, int lane, int wid) {
    const int r32 = lane & 31, hi = lane >> 5;
    LAS float* wsf = (LAS float*)(lds + WSF_OFF) + wid * 32;
    LAS float* st = (LAS float*)(lds + OST_OFF) + wid * 2048 + lane;
    if (hi == 0) wsf[r32] = fac;
    asm volatile("s_waitcnt lgkmcnt(0)" ::: "memory");
#pragma unroll
    for (int r = 0; r < 16; ++r) { const float a = wsf[crow(r, hi)];
        float v0 = o[0][r] * a, v1 = o[1][r] * a;
        if (!first) { v0 += st[(r * 2) * 64]; v1 += st[(r * 2 + 1) * 64]; }
        st[(r * 2) * 64] = v0; st[(r * 2 + 1) * 64] = v1; }
    asm volatile("s_waitcnt lgkmcnt(0)" ::: "memory");
}

template <int BR>
__device__ __forceinline__ void run_branch(LAS unsigned char* lds, const bf16_t* Kg, const bf16_t* Vg, int pitch, int first, int step, int n,
                                           const bf16x8 (&qr)[4], f32x16 (&o)[2], float& m, float& l, float linv,
                                           int t0, int qt, int tok, int head, int lane, int wid) {
    TileRegs R; float carry = 0.f;
    gload(R, Kg, Vg, pitch, first, wid, lane); lstore(R, lds, 0, wid, lane);
    __syncthreads();
    LAS const float* lutr = (LAS const float*)(lds + LUT_OFF) + head * LUT_PITCH;
    const float farb = lutr[128];
    LAS const unsigned* selw = (LAS const unsigned*)(lds + SEL_OFF) + tok * 4;
    for (int k = 0; k < n; ++k) {
        const int tile = first + k * step;
        if (k + 1 < n) gload(R, Kg, Vg, pitch, tile + step, wid, lane);
        int Dbase; bool general; bool rowvalid = true;
        if (BR <= 1) { Dbase = t0 + tok - 31 - 16 * 64 * tile; general = (t0 - 16 * (64 * tile + 63) - 31) < 128; }
        else { Dbase = 64 * (qt - tile) + tok; general = (qt - tile) <= 2 || (BR == 3 && (qt - tile) >= 8); }
        if (BR == 2) rowvalid = (selw[tile >> 5] >> (tile & 31)) & 1u;
        if (BR != 2 || __any(rowvalid))
            tile_compute<BR>(lds, k & 1, qr, o, m, l, linv, Dbase, general, farb, lutr, rowvalid, tok, tile * 16, carry, lane, wid);
        if (k + 1 < n) lstore(R, lds, (k + 1) & 1, wid, lane);
        __syncthreads();
    }
}

__device__ __forceinline__ void nsa_unit(const Params& p, int l, LAS unsigned char* lds, int b, int g, int qt) {
    const int tid = opaque_tid(), lane = tid & 63, wid = __builtin_amdgcn_readfirstlane(tid >> 6), r32 = lane & 31, hi = lane >> 5;
    const bf16_t* PROJ = (const bf16_t*)(p.ws + WS_PROJ);
    const bf16_t* KC = (const bf16_t*)(p.ws + WS_KC) + (size_t)(b * 2 + g) * 512 * 256;
    const bf16_t* VC = (const bf16_t*)(p.ws + WS_VC) + (size_t)(b * 2 + g) * 512 * 256;
    bf16_t* CAT = (bf16_t*)(p.ws + WS_CAT);
    const int t0 = qt * 64; const size_t R0 = (size_t)b * SEQ;
    const int q = wid * 32 + r32, tok = q >> 2, head = q & 3;
    { LAS float* lut = (LAS float*)(lds + LUT_OFF);
      for (int e = tid; e < 4 * 129; e += 512) { const int r = e / 129, d = e % 129; const int bk = d >= 128 ? 31 : rel_bucket_dev(d);
          lut[r * LUT_PITCH + d] = p.in[I_RELB][bk * 8 + g * 4 + r] * LOG2E; }
      if (tid < 256) ((LAS unsigned*)(lds + SEL_OFF))[tid] = 0u; }
    const bf16_t* qrow = PROJ + (R0 + t0 + tok) * DINP;
    bf16x8 qr[4];
#pragma unroll
    for (int d0 = 0; d0 < 4; ++d0) qr[d0] = *(const bf16x8*)(qrow + 768 + (g * 4 + head) * 64 + d0 * 16 + hi * 8);
    float gate[3];
#pragma unroll
    for (int br = 0; br < 3; ++br) gate[br] = 1.f / (1.f + __expf(-bf2f(qrow[2048 + (g * 4 + head) * 3 + br])));
    __syncthreads();
    f32x16 o[2];
    const int nct = (4 * qt + 3 + 63) / 64;
    float mc = NEGV, lc = 0.f;
    o[0] = f32x16{}; o[1] = f32x16{};
    run_branch<0>(lds, KC, VC, 256, 0, 1, nct, qr, o, mc, lc, 0.f, t0, qt, tok, head, lane, wid);
    lc += __shfl_xor(lc, 32);
    const float linvc = (mc > -1e29f && lc > 0.f) ? 1.f / lc : 0.f;
    { float md = 0.f, ld = 0.f; float mcc = mc;
      run_branch<1>(lds, KC, VC, 256, 0, 1, nct, qr, o, mcc, ld, linvc, t0, qt, tok, head, lane, wid); (void)md; }
    accum_branch(lds, o, gate[0], true, lane, wid);
    __syncthreads();
    { LAS float* G = (LAS float*)(lds + IMP_OFF); LAS unsigned* selw = (LAS unsigned*)(lds + SEL_OFF);
      const int i = tid >> 3, sub = tid & 7; const int cur = qt;
      if (cur < 16) { if (sub == 0) { selw[i * 4 + 0] = 0xffffffffu; selw[i * 4 + 1] = 0xffffffffu; selw[i * 4 + 2] = 0xffffffffu; selw[i * 4 + 3] = 0xffffffffu; } }
      else {
          for (int mm = 0; mm < 16; ++mm) { const int j = sub + 8 * mm; if (j <= cur) { float sc;
              if (j == 0 || j == cur || j == cur - 1) G[i * IMP_PITCH + j] = 1e30f; } }
          __syncthreads();
          for (int mm = 0; mm < 16; ++mm) { const int j = sub + 8 * mm; if (j <= cur) { const float sj = G[i * IMP_PITCH + j]; int cnt = 0;
              for (int jj = 0; jj <= cur; ++jj) { const float s2 = G[i * IMP_PITCH + jj]; cnt += (s2 > sj || (s2 == sj && jj < j)) ? 1 : 0; }
              if (cnt < 16) atomicOr((unsigned*)&selw[i * 4 + (j >> 5)], 1u << (j & 31)); } }
      } }
    __syncthreads();
    { float ms = NEGV, ls = 0.f; o[0] = f32x16{}; o[1] = f32x16{};
      run_branch<2>(lds, PROJ + R0 * DINP + 1536 + g * 64, PROJ + R0 * DINP + 1664 + g * 64, DINP, qt, -1, qt + 1, qr, o, ms, ls, 0.f, t0, qt, tok, head, lane, wid);
      ls += __shfl_xor(ls, 32);
      accum_branch(lds, o, gate[1] / ls, false, lane, wid); }
    { float mw = NEGV, lw = 0.f; o[0] = f32x16{}; o[1] = f32x16{};
      const int nw = qt + 1 < 9 ? qt + 1 : 9;
      run_branch<3>(lds, PROJ + R0 * DINP + 1792 + g * 64, PROJ + R0 * DINP + 1920 + g * 64, DINP, qt, -1, nw, qr, o, mw, lw, 0.f, t0, qt, tok, head, lane, wid);
      lw += __shfl_xor(lw, 32);
      accum_branch(lds, o, gate[2] / lw, false, lane, wid); }
    { LAS const float* st = (LAS const float*)(lds + OST_OFF) + wid * 2048 + lane;
#pragma unroll
    for (int r = 0; r < 16; ++r) { const int qq = wid * 32 + crow(r, hi); const int tk = qq >> 2, hd = qq & 3;
        bf16_t* dst = CAT + (R0 + t0 + tk) * DM + 512 + (g * 4 + hd) * 64 + r32;
        dst[0] = (bf16_t)f2bf(st[(r * 2) * 64]); dst[32] = (bf16_t)f2bf(st[(r * 2 + 1) * 64]); } }
    __syncthreads();
}

__device__ __forceinline__ void nsa_phase(const Params& p, int l, LAS unsigned char* lds, int vcu, int G) {
    for (int v = vcu; v < 256; v += G) {
        const int bg = v >> 4, s = v & 15;
        for (int i = 0; i < 8; ++i) { const int qt = (i >> 1) * 32 + ((i & 1) ? 31 - s : s); nsa_unit(p, l, lds, bg >> 1, bg & 1, qt); }
    }
}
}


#define XB_TMO      128
#define XB_XCNT(j)  (256  + 64 * (j))
#define XB_XSUB(j)  (1280 + 64 * (j))
#define XB_XGEN(j)  (2304 + 64 * (j))
#define XB_TOP      3328
#define XB_TOPGEN   3392
#define XCD_BAR_WORDS 3456
#define XB_SPIN_CAP (1u << 22)
__device__ __forceinline__ unsigned xb_ld(unsigned* p)              { return __hip_atomic_load(p, __ATOMIC_RELAXED, __HIP_MEMORY_SCOPE_AGENT); }
__device__ __forceinline__ unsigned xb_add(unsigned* p, unsigned v) { return __hip_atomic_fetch_add(p, v, __ATOMIC_RELAXED, __HIP_MEMORY_SCOPE_AGENT); }
__device__ __forceinline__ unsigned xb_xcc_id() { return (unsigned)__builtin_amdgcn_s_getreg((3 << 11) | 20) & 0xFu; }
#define XB_SPIN(cond, bar) do { unsigned _sp = 0; while (cond) { __builtin_amdgcn_s_sleep(1); \
    if ((++_sp & 255u) == 0u) { if (xb_ld(&(bar)[XB_TMO])) break; if (_sp > XB_SPIN_CAP) { atomicAdd(&(bar)[XB_TMO], 1u); break; } } } } while (0)
struct XcdBarrier { unsigned* bar; unsigned x; volatile LAS unsigned* st; };
__device__ __forceinline__ XcdBarrier xcd_barrier_post(unsigned* bar, volatile LAS unsigned* st) {
    XcdBarrier b; b.bar = bar; b.x = xb_xcc_id(); b.st = st;
    if (threadIdx.x == 0) (void)xb_add(&bar[XB_XCNT(b.x)], 1u);
    return b;
}
__device__ __forceinline__ void xcd_barrier_complete(unsigned* bar, unsigned x, unsigned& nloc, unsigned& nx) {
    const unsigned G = gridDim.x * gridDim.y * gridDim.z;
    unsigned sum, cnt, mine, sp = 0u;
    for (;;) {
        sum = 0u; cnt = 0u; mine = 0u;
#pragma unroll
        for (unsigned j = 0; j < 16; ++j) { const unsigned c = xb_ld(&bar[XB_XCNT(j)]); sum += c; cnt += (c > 0u) ? 1u : 0u; mine = (j == x) ? c : mine; }
        if (sum == G) break;
        __builtin_amdgcn_s_sleep(1);
        if ((++sp & 255u) == 0u) { if (xb_ld(&bar[XB_TMO])) break; if (sp > XB_SPIN_CAP) { atomicAdd(&bar[XB_TMO], 1u); break; } }
    }
    nloc = mine > 0u ? mine : 1u; nx = cnt > 0u ? cnt : 1u;
}
__device__ __forceinline__ void xcd_barrier(const XcdBarrier& b) {
    asm volatile("s_waitcnt vmcnt(0)" ::: "memory");
    __syncthreads();
    if (threadIdx.x == 0) {
        unsigned* bar = b.bar;
        __builtin_amdgcn_s_waitcnt(0);
        unsigned nloc = b.st[0], nx = b.st[1];
        if (nloc == 0u) { xcd_barrier_complete(bar, b.x, nloc, nx); b.st[0] = nloc; b.st[1] = nx; }
        const unsigned old = xb_add(&bar[XB_XSUB(b.x)], 1u);
        const unsigned gen = old / nloc;
        if (old + 1u == (gen + 1u) * nloc) {
            __builtin_amdgcn_fence(__ATOMIC_RELEASE, "agent");
            asm volatile("s_waitcnt vmcnt(0)" ::: "memory");
            const unsigned og = xb_add(&bar[XB_TOP], 1u);
            const unsigned tg = og / nx;
            if (og + 1u == (tg + 1u) * nx) xb_add(&bar[XB_TOPGEN], 1u);
            else XB_SPIN(xb_ld(&bar[XB_TOPGEN]) == tg, bar);
            __builtin_amdgcn_fence(__ATOMIC_ACQUIRE, "agent");
            xb_add(&bar[XB_XGEN(b.x)], 1u);
            asm volatile("s_waitcnt vmcnt(0)" ::: "memory");
        } else {
            XB_SPIN(xb_ld(&bar[XB_XGEN(b.x)]) == gen, bar);
            __builtin_amdgcn_fence(__ATOMIC_ACQUIRE, "agent");
            asm volatile("s_waitcnt vmcnt(0)" ::: "memory");
        }
    }
    __syncthreads();
}

__global__ void __launch_bounds__(512) hybrid_fwd(Params p) {
    extern __shared__ __attribute__((aligned(16))) unsigned char lds_raw[];
    LAS unsigned char* lds = (LAS unsigned char*)lds_raw;
    cg::grid_group grid = cg::this_grid();
    const int G = gridDim.x, bx = blockIdx.x;
    const int vcu = (G % 8 == 0) ? (bx % 8) * (G / 8) + bx / 8 : bx;
    unsigned char* ws = p.ws;
    volatile LAS unsigned* misc = (volatile LAS unsigned*)(lds + 139264);
    if (threadIdx.x < 2) misc[threadIdx.x] = 0u;
    __syncthreads();
    const XcdBarrier xbar = xcd_barrier_post((unsigned*)ws, misc);
    for (int ph = p.ph_lo; ph < p.ph_hi; ++ph) {
        if (ph == 0) prologue_phase(p, lds, vcu, G);
        else {
            const int l = (ph - 1) / 15, k = (ph - 1) % 15 + 1;
            unsigned char* wl = ws + WS_W + (size_t)l * WS_WL;
            int njobs = 0;
            if (k == 1) njobs = (l == 0) ? 5 : 1; else if (k == 3) njobs = 4; else if (k == 4) njobs = 2;
            else if (k == 6 || k == 8 || k == 9 || k == 10 || k == 11 || k == 13 || k == 14) njobs = 1;
            for (int job = 0; job < njobs; ++job) {
                pg8::Gemm g; pg8::Epi E; int M = MTOK, N = DM, c0 = 0;
                g.a_pn = 0; g.b_batch = 0; g.mtpb = 1 << 30; g.lda = DM; g.ldb = DM; g.K = DM;
                E.bias = nullptr; E.act = 0; E.sc_lo = 0; E.sc_hi = 0; E.sc = 1.f; E.ldc = DM;
                if (k == 1 && job == 0) { g.A = (const bf16_t*)(ws + WS_XN); g.Bt = (const bf16_t*)(wl + W_IN); N = DINP; E.O = (bf16_t*)(ws + WS_PROJ); E.ldc = DINP; E.sc_lo = 3; E.sc_hi = 5; E.sc = 0.125f * LOG2E; }
                else if (k == 1) { const int ll = (job - 1) >> 1; unsigned char* w2 = ws + WS_W + (size_t)ll * WS_WL;
                    if ((job - 1) & 1) { g.A = (const bf16_t*)(w2 + W_V); g.Bt = (const bf16_t*)(w2 + W_MEMN); M = DM; N = NB * NMEM; E.O = (bf16_t*)(ws + WS_VMT + (size_t)ll * 4 * MiB); E.ldc = NB * NMEM; }
                    else { g.A = (const bf16_t*)(w2 + W_MEMN); g.Bt = (const bf16_t*)(w2 + W_K); M = NB * NMEM; N = DM; E.O = (bf16_t*)(ws + WS_KM + (size_t)ll * 4 * MiB); }
                    c0 = 32 * (job - 1); }
                else if (k == 3 && job < 2) { g.A = (const bf16_t*)(ws + (job ? WS_VCRAW : WS_KCRAW)); g.lda = 1024; g.K = 2048; g.Bt = (const bf16_t*)(wl + (job ? W_CV1 : W_CK1)); g.ldb = 2048;
                    M = 8192; N = 256; E.O = (bf16_t*)(ws + (job ? WS_HIDV : WS_HIDK)); E.ldc = 256; E.act = 2; E.bias = (const float*)(wl + (job ? W_CB1V : W_CB1K)); c0 = job * 32; }
                else if (k == 3) { g.A = (const bf16_t*)(ws + WS_ACT) + (job == 3 ? 256 : 0); g.lda = 512; g.K = 256; g.Bt = (const bf16_t*)(wl + (job == 3 ? W_CPW : W_POOL)); g.ldb = 256;
                    N = 256; E.O = (bf16_t*)(ws + WS_CAT) + (job == 3 ? 256 : 0); c0 = 64; }
                else if (k == 4) { g.A = (const bf16_t*)(ws + (job ? WS_HIDV : WS_HIDK)); g.lda = 256; g.K = 256; g.Bt = (const bf16_t*)(wl + (job ? W_CV2 : W_CK2)); g.ldb = 256;
                    M = 8192; N = 256; E.O = (bf16_t*)(ws + (job ? WS_VC : WS_KC)); E.ldc = 256; c0 = job * 32; }
                else if (k == 6) { g.A = (const bf16_t*)(ws + WS_CAT); g.Bt = (const bf16_t*)(wl + W_OUT); E.O = (bf16_t*)(ws + WS_MIX); }
                else if (k == 8) { g.A = (const bf16_t*)(ws + WS_XN); g.Bt = (const bf16_t*)(wl + W_Q); E.O = (bf16_t*)(ws + WS_CAT); E.sc_lo = 0; E.sc_hi = 4; E.sc = 0.0625f * LOG2E; }
                else if (k == 9) { g.A = (const bf16_t*)(ws + WS_CAT); g.a_pn = 256; g.K = 256; g.Bt = (const bf16_t*)(ws + WS_KM + (size_t)l * 4 * MiB); g.b_pn = 256; g.b_batch = (size_t)NMEM * DM; g.mtpb = 32;
                    E.O = (bf16_t*)(ws + WS_PROJ); E.act = 3; }
                else if (k == 10) { g.A = (const bf16_t*)(ws + WS_PROJ); g.a_pn = 256; g.K = 256; g.Bt = (const bf16_t*)(ws + WS_VMT + (size_t)l * 4 * MiB); g.ldb = NB * NMEM; g.b_pn = (size_t)256 * NB * NMEM; g.b_batch = 256; g.mtpb = 32;
                    E.O = (bf16_t*)(ws + WS_CAT); }
                else if (k == 11) { g.A = (const bf16_t*)(ws + WS_CAT); g.Bt = (const bf16_t*)(wl + W_O); E.O = (bf16_t*)(ws + WS_MIX); }
                else if (k == 13) { g.A = (const bf16_t*)(ws + WS_XN); g.Bt = (const bf16_t*)(wl + W_1); N = FF; E.O = (bf16_t*)(ws + WS_HID); E.ldc = FF; E.act = 1; }
                else { g.A = (const bf16_t*)(ws + WS_HID); g.lda = FF; g.K = FF; g.Bt = (const bf16_t*)(wl + W_2); g.ldb = FF; E.O = (bf16_t*)(ws + WS_MIX); }
                if (!(k == 9 || k == 10)) g.b_pn = (size_t)256 * g.ldb;
                pg8::StaticOrder S; S.init(M, N, G, (bx - c0 + 4 * G) % G);
                pg8::gemm_phase(lds, g, S, E);
            }
            if (k == 2) prep_phase(p, l, lds, vcu, G);
            else if (k == 5) nsa::nsa_phase(p, l, lds, vcu, G);
            else if (k == 7) rowwise_phase(l == 0 ? p.in[I_X] : p.out, p.out, (const bf16_t*)(ws + WS_MIX), p.in[I_MIXPOST] + l * DM, p.in[I_XAPRE] + l * DM, (bf16_t*)(ws + WS_XN), vcu, G);
            else if (k == 12) rowwise_phase(p.out, p.out, (const bf16_t*)(ws + WS_MIX), p.in[I_XAPOST] + l * DM, p.in[I_MLPPRE] + l * DM, (bf16_t*)(ws + WS_XN), vcu, G);
            else if (k == 15) rowwise_phase(p.out, p.out, (const bf16_t*)(ws + WS_MIX), p.in[I_MLPPOST] + l * DM, l == 0 ? p.in[I_MIXPRE] + DM : nullptr, (bf16_t*)(ws + WS_XN), vcu, G);
        }
        if (ph + 1 < p.ph_hi) { if (ph == 0) grid.sync(); else xcd_barrier(xbar); }
    }
}

extern "C" void kernel_launch(void* const* d_in, const int* in_sizes, int n_in, void* d_out, int out_size, void* d_ws, size_t ws_size, hipStream_t stream) {
    static int grid = 0;
    if (grid == 0) {
        if (n_in != 31 || ws_size < WS_END) { fprintf(stderr, "kernel_launch: unexpected inputs (n_in %d, ws %zu)\n", n_in, ws_size); grid = -1; return; }
        int dev = 0, cus = 0, per_cu = 0;
        hipGetDevice(&dev); hipDeviceGetAttribute(&cus, hipDeviceAttributeMultiprocessorCount, dev);
        hipFuncSetAttribute((const void*)hybrid_fwd, hipFuncAttributeMaxDynamicSharedMemorySize, LDS_BYTES);
        hipOccupancyMaxActiveBlocksPerMultiprocessor(&per_cu, (const void*)hybrid_fwd, 512, LDS_BYTES);
        (void)hipGetLastError();
        if (per_cu < 1) fprintf(stderr, "kernel_launch: occupancy query says %d blocks per CU\n", per_cu);
        grid = cus;
    }
    if (grid < 0) return;
    Params p{};
    for (int i = 0; i < 31; ++i) p.in[i] = (const float*)d_in[i];
    p.out = (float*)d_out; p.ws = (unsigned char*)d_ws; p.ph_lo = 0; p.ph_hi = 31;
    void* args[] = {&p};
    (void)hipMemsetAsync(d_ws, 0, 16384, stream);
    hipError_t e = hipLaunchCooperativeKernel((const void*)hybrid_fwd, dim3(grid), dim3(512), args, LDS_BYTES, stream);
    if (e != hipSuccess) fprintf(stderr, "cooperative launch failed: %s (grid %d)\n", hipGetErrorString(e), grid);
}
```

```cpp
#include <hip/hip_runtime.h>
#include <hip/hip_cooperative_groups.h>
#include <cstdio>
#include <cstdint>
#include <cmath>
namespace cg = cooperative_groups;

#define LAS __attribute__((address_space(3)))
typedef unsigned short bf16_t;
typedef short bf16x8 __attribute__((ext_vector_type(8)));
typedef short s16x4 __attribute__((ext_vector_type(4)));
typedef float f32x4 __attribute__((ext_vector_type(4)));
typedef float f32x2 __attribute__((ext_vector_type(2)));
typedef float f32x16 __attribute__((ext_vector_type(16)));
typedef unsigned u32x4 __attribute__((ext_vector_type(4)));
typedef unsigned u32x2 __attribute__((ext_vector_type(2)));

constexpr int NB = 8, SEQ = 8192, DM = 1024, MTOK = NB * SEQ, DINP = 2304, FF = 4096, NMEM = 256;
constexpr float LOG2E = 1.4426950408889634f;
constexpr float EPS = 1e-6f;
constexpr float NEGV = -1e30f;

constexpr size_t MiB = 1u << 20;
constexpr size_t WS_W = 1 * MiB, WS_WL = 40 * MiB;
constexpr size_t W_IN = 0, W_OUT = 5 * MiB, W_Q = 7 * MiB, W_O = 9 * MiB, W_1 = 11 * MiB, W_2 = 19 * MiB, W_K = 27 * MiB, W_V = 29 * MiB,
                 W_CK1 = 31 * MiB, W_CV1 = 32 * MiB, W_CK2 = 33 * MiB, W_CV2 = 33 * MiB + 128 * 1024, W_POOL = 33 * MiB + 256 * 1024,
                 W_CPW = 33 * MiB + 384 * 1024, W_CB1K = 33 * MiB + 512 * 1024, W_CB1V = 33 * MiB + 516 * 1024, W_MEMN = 34 * MiB;
constexpr size_t WS_KM = 82 * MiB, WS_VMT = 90 * MiB;
constexpr size_t WS_KCRAW = 100 * MiB, WS_VCRAW = 117 * MiB;
constexpr size_t WS_HIDK = 134 * MiB, WS_HIDV = 138 * MiB, WS_KC = 142 * MiB, WS_VC = 146 * MiB;
constexpr size_t WS_XN = 160 * MiB, WS_MIX = 288 * MiB, WS_BIG = 416 * MiB;
constexpr size_t WS_PROJ = WS_BIG, WS_CAT = 704 * MiB, WS_ACT = 832 * MiB, WS_HID = WS_BIG;
constexpr size_t WS_END = 928 * MiB;

constexpr int LDS_BYTES = 153600;
constexpr int MISC_OFF = 152576;
constexpr int XS_OFF = 131072;

__device__ __forceinline__ unsigned f2bf(float f) { unsigned u = __builtin_bit_cast(unsigned, f); return (u + 0x7fffu + ((u >> 16) & 1u)) >> 16; }
__device__ __forceinline__ unsigned pk2(float lo, float hi) { return f2bf(lo) | (f2bf(hi) << 16); }
__device__ __forceinline__ float bf2f(unsigned short b) { return __builtin_bit_cast(float, (unsigned)b << 16); }
__device__ __forceinline__ unsigned cvt_pk_bf16(float lo, float hi) { unsigned r; asm volatile("v_cvt_pk_bf16_f32 %0, %1, %2" : "=v"(r) : "v"(lo), "v"(hi)); return r; }
__device__ __forceinline__ float wave_sum(float v) {
#pragma unroll
    for (int o = 1; o < 64; o <<= 1) v += __shfl_xor(v, o);
    return v;
}
__device__ __forceinline__ float ex2(float x) { return __builtin_amdgcn_exp2f(x); }
__device__ __forceinline__ int opaque_tid() { int t = threadIdx.x; asm volatile("" : "+v"(t)); return t; }

namespace pg8 {
constexpr int BM = 256, BK = 64, HALF = 128, HTB = HALF * BK * 2, STAGE_BYTES = 8 * HTB, NXCD = 8, WGM = 8;
__host__ __device__ __forceinline__ int lds_byte(int r, int c) { const int st = (r >> 4) * 2 + (c >> 5), rr = r & 15, cc = c & 31, ob = rr * 64 + cc * 2; return st * 1024 + (ob ^ (((ob >> 9) & 1) << 5)); }
__host__ __device__ __forceinline__ void stage_rc(int b, int& R, int& C) { const int st = b / 1024, sb = b % 1024, swz = sb ^ (((sb >> 9) & 1) << 5); R = (st >> 1) * 16 + swz / 64; C = (st & 1) * 32 + (swz % 64) / 2; }
__host__ __device__ __forceinline__ int perm32(int rho) { const int n = rho >> 4, i = rho & 15; return 8 * (i >> 2) + 4 * n + (i & 3); }

struct Unit { int pm, pn; };
struct Gemm {
    const bf16_t* A; const bf16_t* Bt; int lda, ldb, K; size_t a_pn, b_pn, b_batch; int mtpb;
    __device__ __forceinline__ const char* a_ptr(const Unit& u) const { return (const char*)(A + (size_t)u.pm * BM * lda + (size_t)u.pn * a_pn); }
    __device__ __forceinline__ const char* b_ptr(const Unit& u) const { return (const char*)(Bt + (size_t)u.pn * b_pn + (size_t)(u.pm / mtpb) * b_batch); }
};
struct StaticOrder {
    int nM, nN, nwg, G, c;
    __device__ void init(int M, int N, int G_, int c_) { nM = M / BM; nN = N / BM; nwg = nM * nN; G = G_; c = c_; }
    __device__ bool next(int i, Unit& u) const {
        const long L = (long)i * G + c; if (L >= nwg) return false;
        int wgid = (int)L; { const int q = nwg / NXCD, r = nwg % NXCD, xcd = wgid % NXCD, off = wgid / NXCD; wgid = (xcd < r ? xcd * (q + 1) : r * (q + 1) + (xcd - r) * q) + off; }
        const int nig = WGM * nN, gid = wgid / nig, fm = gid * WGM, gsz = (nM - fm) < WGM ? (nM - fm) : WGM;
        u.pm = fm + ((wgid % nig) % gsz); u.pn = (wgid % nig) / gsz; return true;
    }
};

struct Epi {
    bf16_t* O; int ldc; const float* bias; int act; int sc_lo, sc_hi; float sc;
    __device__ __forceinline__ void operator()(f32x4 (&acc)[2][2][4][2], const Unit& u, int wr, int wc, int fr, int fq, LAS unsigned char* xs) const {
        const int row0 = u.pm * BM + wr * 64 + fr; const int col0 = u.pn * BM + wc * 32 + 8 * fq;
        const float s = (u.pn >= sc_lo && u.pn < sc_hi) ? sc : 1.f;
        if (act == 3) {
            LAS f32x2* XS = (LAS f32x2*)xs;
            float mloc[2][4];
#pragma unroll
            for (int ai = 0; ai < 2; ++ai)
#pragma unroll
                for (int m = 0; m < 4; ++m) {
                    float mx = NEGV;
#pragma unroll
                    for (int bj = 0; bj < 2; ++bj)
#pragma unroll
                        for (int n = 0; n < 2; ++n) { const f32x4 x = acc[ai][bj][m][n]; mx = fmaxf(mx, fmaxf(fmaxf(x[0], x[1]), fmaxf(x[2], x[3]))); }
                    mx = fmaxf(mx, __shfl_xor(mx, 16)); mx = fmaxf(mx, __shfl_xor(mx, 32));
                    float sm = 0.f;
#pragma unroll
                    for (int bj = 0; bj < 2; ++bj)
#pragma unroll
                        for (int n = 0; n < 2; ++n) { f32x4 x = acc[ai][bj][m][n]; x[0] = ex2(x[0] - mx); x[1] = ex2(x[1] - mx); x[2] = ex2(x[2] - mx); x[3] = ex2(x[3] - mx); acc[ai][bj][m][n] = x; sm += (x[0] + x[1]) + (x[2] + x[3]); }
                    sm += __shfl_xor(sm, 16); sm += __shfl_xor(sm, 32);
                    mloc[ai][m] = mx;
                    if (fq == 0) XS[(ai * HALF + wr * 64 + m * 16 + fr) * 4 + wc] = (f32x2){mx, sm};
                }
            asm volatile("s_waitcnt lgkmcnt(0)" ::: "memory"); __builtin_amdgcn_s_barrier(); asm volatile("" ::: "memory");
#pragma unroll
            for (int ai = 0; ai < 2; ++ai)
#pragma unroll
                for (int m = 0; m < 4; ++m) {
                    const int r = ai * HALF + wr * 64 + m * 16 + fr;
                    const f32x2 a = XS[r * 4 + 0], b = XS[r * 4 + 1], c = XS[r * 4 + 2], d = XS[r * 4 + 3];
                    const float mt = fmaxf(fmaxf(a.x, b.x), fmaxf(c.x, d.x));
                    const float l = a.y * ex2(a.x - mt) + b.y * ex2(b.x - mt) + c.y * ex2(c.x - mt) + d.y * ex2(d.x - mt);
                    const float f = ex2(mloc[ai][m] - mt) / l;
                    bf16_t* rowp = O + (size_t)(row0 + ai * HALF + m * 16) * ldc + col0;
#pragma unroll
                    for (int bj = 0; bj < 2; ++bj) { const f32x4 v0 = acc[ai][bj][m][0] * f, v1 = acc[ai][bj][m][1] * f;
                        u32x4 w; w.x = cvt_pk_bf16(v0[0], v0[1]); w.y = cvt_pk_bf16(v0[2], v0[3]); w.z = cvt_pk_bf16(v1[0], v1[1]); w.w = cvt_pk_bf16(v1[2], v1[3]);
                        *(u32x4*)(rowp + bj * HALF) = w; }
                }
            return;
        }
        f32x4 bv[2][2];
#pragma unroll
        for (int bj = 0; bj < 2; ++bj)
#pragma unroll
            for (int n = 0; n < 2; ++n) bv[bj][n] = bias ? *(const f32x4*)(bias + col0 + bj * HALF + 4 * n) : (f32x4){0.f, 0.f, 0.f, 0.f};
#pragma unroll
        for (int ai = 0; ai < 2; ++ai)
#pragma unroll
            for (int m = 0; m < 4; ++m) { bf16_t* rowp = O + (size_t)(row0 + ai * HALF + m * 16) * ldc + col0;
#pragma unroll
                for (int bj = 0; bj < 2; ++bj) { f32x4 v0 = acc[ai][bj][m][0] + bv[bj][0], v1 = acc[ai][bj][m][1] + bv[bj][1];
                    if (act == 1) {
#pragma unroll
                        for (int e = 0; e < 4; ++e) { float a = fmaxf(v0[e], 0.f), b = fmaxf(v1[e], 0.f); v0[e] = a * a; v1[e] = b * b; }
                    } else if (act == 2) {
#pragma unroll
                        for (int e = 0; e < 4; ++e) { float a = v0[e], b = v1[e];
                            float ua = 1.5957691216f * (a + 0.044715f * a * a * a), ub = 1.5957691216f * (b + 0.044715f * b * b * b);
                            v0[e] = a / (1.f + __expf(-ua)); v1[e] = b / (1.f + __expf(-ub)); }
                    }
                    v0 = v0 * s; v1 = v1 * s; u32x4 w; w.x = cvt_pk_bf16(v0[0], v0[1]); w.y = cvt_pk_bf16(v0[2], v0[3]); w.z = cvt_pk_bf16(v1[0], v1[1]); w.w = cvt_pk_bf16(v1[2], v1[3]);
                    *(u32x4*)(rowp + bj * HALF) = w; } }
    }
};

__device__ __forceinline__ void gemm_phase(LAS unsigned char* lds, const Gemm g, const StaticOrder& S, const Epi& E) {
    const int tid = opaque_tid(), wid = __builtin_amdgcn_readfirstlane(tid >> 6), lane = tid & 63, wr = wid >> 2, wc = wid & 3, fr = lane & 15, fq = lane >> 4;
    const int K = g.K, nt = K / BK;
    unsigned voffA[2], voffB[2];
#pragma unroll
    for (int i = 0; i < 2; ++i) { int R, C; stage_rc(tid * 16 + i * 8192, R, C); const int Rb = (R & ~31) + perm32(R & 31);
        voffA[i] = (unsigned)(R * g.lda + C) * 2u; voffB[i] = (unsigned)(Rb * g.ldb + C) * 2u; }
    const size_t kstep = (size_t)(BK * 2);
    const size_t hA = (size_t)HALF * g.lda * 2, hB = (size_t)HALF * g.ldb * 2;
    const unsigned ldsw = (unsigned)wid * 1024u;
    const int aoff = lds_byte(wr * 64 + fr, fq * 8), boff = lds_byte(wc * 32 + fr, fq * 8);
#define PG8_SA(b, h) (((b) * 2 + (h)) * HTB)
#define PG8_SB(b, h) ((4 + (b) * 2 + (h)) * HTB)
#define PG8_STAGE(bufoff, gbase, voff) do { _Pragma("unroll") for (int _i = 0; _i < 2; ++_i) \
        __builtin_amdgcn_global_load_lds((const unsigned*)((const char*)(gbase) + (voff)[_i]), (LAS unsigned*)(lds + (bufoff) + ldsw + _i * 8192), 16, 0, 0); } while (0)
#define PG8_LDA(dst, b, h) do { _Pragma("unroll") for (int m = 0; m < 4; ++m) _Pragma("unroll") for (int k = 0; k < 2; ++k) dst[m][k] = *(const LAS bf16x8*)(lds + PG8_SA(b, h) + aoff + m * 2048 + k * 1024); } while (0)
#define PG8_LDB(dst, b, h) do { _Pragma("unroll") for (int n = 0; n < 2; ++n) _Pragma("unroll") for (int k = 0; k < 2; ++k) dst[n][k] = *(const LAS bf16x8*)(lds + PG8_SB(b, h) + boff + n * 2048 + k * 1024); } while (0)
#define PG8_MMA(ai, bj, At, Bt) do { __builtin_amdgcn_s_setprio(1); _Pragma("unroll") for (int m = 0; m < 4; ++m) _Pragma("unroll") for (int n = 0; n < 2; ++n) _Pragma("unroll") for (int k = 0; k < 2; ++k) \
        acc[ai][bj][m][n] = __builtin_amdgcn_mfma_f32_16x16x32_bf16(Bt[n][k], At[m][k], acc[ai][bj][m][n], 0, 0, 0); __builtin_amdgcn_s_setprio(0); } while (0)
#define PG8_WAIT_V(n) asm volatile("s_waitcnt vmcnt(" #n ")" ::: "memory")
#define PG8_WAIT_L(n) asm volatile("s_waitcnt lgkmcnt(" #n ")" ::: "memory")
#define PG8_BAR __builtin_amdgcn_s_barrier()
#define PG8_SCHED __builtin_amdgcn_sched_barrier(0)
    Unit cur, nxt; int ui = 0;
    if (!S.next(0, cur)) return;
    f32x4 acc[2][2][4][2];
#pragma unroll
    for (int a = 0; a < 2; ++a)
#pragma unroll
        for (int b = 0; b < 2; ++b)
#pragma unroll
            for (int m = 0; m < 4; ++m)
#pragma unroll
                for (int n = 0; n < 2; ++n) acc[a][b][m][n] = (f32x4){0.f, 0.f, 0.f, 0.f};
    bf16x8 At[4][2], B0[2][2], B1[2][2];
    const char* cA = g.a_ptr(cur); const char* cB = g.b_ptr(cur);
    PG8_STAGE(PG8_SB(0, 0), cB, voffB); PG8_STAGE(PG8_SB(0, 1), cB + hB, voffB); PG8_STAGE(PG8_SA(0, 0), cA, voffA); PG8_STAGE(PG8_SA(0, 1), cA + hA, voffA);
    if (wr == 1) PG8_BAR;
    PG8_WAIT_V(2); PG8_BAR;
    PG8_STAGE(PG8_SB(1, 0), cB + kstep, voffB); PG8_STAGE(PG8_SA(1, 0), cA + kstep, voffA); PG8_STAGE(PG8_SB(1, 1), cB + hB + kstep, voffB);
    PG8_WAIT_V(6); PG8_BAR;
    for (;;) {
        const bool has_next = S.next(ui + 1, nxt);
        const char* nA = has_next ? g.a_ptr(nxt) : cA; const char* nB = has_next ? g.b_ptr(nxt) : cB;
        for (int t = 0; t < nt; t += 2) {
            const bool last = (t == nt - 2);
            const char* a1 = cA + (size_t)(t + 1) * kstep;
            const char* a2 = last ? nA : cA + (size_t)(t + 2) * kstep; const char* b2 = last ? nB : cB + (size_t)(t + 2) * kstep;
            const char* a3 = a2 + kstep; const char* b3 = b2 + kstep;
            PG8_LDB(B0, 0, 0); PG8_LDB(B1, 0, 1); PG8_SCHED; PG8_LDA(At, 0, 0); PG8_STAGE(PG8_SA(1, 1), a1 + hA, voffA);
            PG8_WAIT_V(8); PG8_WAIT_L(0); PG8_BAR; PG8_MMA(0, 0, At, B0); PG8_MMA(0, 1, At, B1); PG8_BAR; PG8_SCHED;
            PG8_LDA(At, 0, 1); PG8_STAGE(PG8_SB(0, 0), b2, voffB); PG8_STAGE(PG8_SB(0, 1), b2 + hB, voffB); PG8_STAGE(PG8_SA(0, 0), a2, voffA);
            PG8_WAIT_V(8); PG8_WAIT_L(0); PG8_BAR; PG8_MMA(1, 0, At, B0); PG8_MMA(1, 1, At, B1); PG8_BAR; PG8_SCHED;
            PG8_LDB(B0, 1, 0); PG8_LDB(B1, 1, 1); PG8_SCHED; PG8_LDA(At, 1, 0); PG8_STAGE(PG8_SA(0, 1), a2 + hA, voffA);
            PG8_WAIT_V(8); PG8_WAIT_L(0); PG8_BAR; PG8_MMA(0, 0, At, B0); PG8_MMA(0, 1, At, B1); PG8_BAR; PG8_SCHED;
            PG8_LDA(At, 1, 1); PG8_STAGE(PG8_SB(1, 0), b3, voffB); PG8_STAGE(PG8_SB(1, 1), b3 + hB, voffB); PG8_STAGE(PG8_SA(1, 0), a3, voffA);
            PG8_WAIT_V(8); PG8_WAIT_L(0); PG8_BAR; PG8_MMA(1, 0, At, B0); PG8_MMA(1, 1, At, B1); PG8_BAR; PG8_SCHED;
        }
        if (wr == 0) PG8_BAR;
        E(acc, cur, wr, wc, fr, fq, lds + XS_OFF);
        if (!has_next) break;
#pragma unroll
        for (int a = 0; a < 2; ++a)
#pragma unroll
            for (int b = 0; b < 2; ++b)
#pragma unroll
                for (int m = 0; m < 4; ++m)
#pragma unroll
                    for (int n = 0; n < 2; ++n) acc[a][b][m][n] = (f32x4){0.f, 0.f, 0.f, 0.f};
        cur = nxt; cA = nA; cB = nB; ++ui;
        if (wr == 1) PG8_BAR;
    }
    PG8_WAIT_V(0);
    PG8_BAR;
#undef PG8_SA
#undef PG8_SB
#undef PG8_STAGE
#undef PG8_LDA
#undef PG8_LDB
#undef PG8_MMA
#undef PG8_WAIT_V
#undef PG8_WAIT_L
#undef PG8_BAR
#undef PG8_SCHED
}
}

struct Params {
    const float* in[31];
    float* out;
    unsigned char* ws;
    int ph_lo, ph_hi;
};
enum { I_X = 0, I_MEM, I_RELB, I_MIXPRE, I_MIXPOST, I_WIN, I_POOLW, I_POOLS, I_CONVW, I_CONVB, I_CLNG, I_CLNB, I_CPW, I_CKPOS, I_CKW1, I_CKW2,
       I_CVPOS, I_CVW1, I_CVW2, I_WOUT, I_XAPRE, I_XAPOST, I_MEMG, I_WQ, I_WK, I_WV, I_WO, I_MLPPRE, I_MLPPOST, I_W1, I_W2 };

__device__ __forceinline__ void tr_item(const float* W, int K, int N, int Npad, bf16_t* WT, LAS float* scr, int item, int lane) {
    const int nblk = Npad / 32, kb = item / nblk, nb = item % nblk, k0 = 64 * kb, n0 = 32 * nb;
    const int nn = n0 + (lane & 31);
#pragma unroll 8
    for (int i = 0; i < 32; ++i) { const int kk = 2 * i + (lane >> 5); scr[kk * 33 + (lane & 31)] = (nn < N) ? W[(size_t)(k0 + kk) * N + nn] : 0.f; }
    asm volatile("s_waitcnt lgkmcnt(0)" ::: "memory");
    const int c = lane & 7;
#pragma unroll
    for (int j = 0; j < 4; ++j) { const int n = (lane >> 3) + 8 * j; const LAS float* s = scr + (8 * c) * 33 + n;
        u32x4 o; o.x = pk2(s[0 * 33], s[1 * 33]); o.y = pk2(s[2 * 33], s[3 * 33]); o.z = pk2(s[4 * 33], s[5 * 33]); o.w = pk2(s[6 * 33], s[7 * 33]);
        *(u32x4*)(WT + (size_t)(n0 + n) * K + k0 + 8 * c) = o; }
    asm volatile("s_waitcnt lgkmcnt(0)" ::: "memory");
}
__device__ __forceinline__ void rms_row_to_bf16(const float* xrow, const float* g, bf16_t* orow, int lane) {
    const f32x4* xr = (const f32x4*)xrow + lane; const f32x4* gr = (const f32x4*)g + lane;
    f32x4 v[4]; float s = 0.f;
#pragma unroll
    for (int j = 0; j < 4; ++j) { v[j] = xr[64 * j]; s += (v[j].x * v[j].x + v[j].y * v[j].y) + (v[j].z * v[j].z + v[j].w * v[j].w); }
    const float rstd = 1.f / sqrtf(wave_sum(s) * (1.f / DM) + EPS);
    u32x2* o8 = (u32x2*)orow + lane;
#pragma unroll
    for (int j = 0; j < 4; ++j) { const f32x4 gg = gr[64 * j]; u32x2 w; w.x = pk2(v[j].x * rstd * gg.x, v[j].y * rstd * gg.y); w.y = pk2(v[j].z * rstd * gg.z, v[j].w * rstd * gg.w); o8[64 * j] = w; }
}

__device__ __forceinline__ void prologue_phase(const Params& p, LAS unsigned char* lds, int vcu, int G) {
    const int tid = opaque_tid(), lane = tid & 63, wave = tid >> 6;
    LAS float* scr = (LAS float*)(lds + wave * 16384);
    const int gw = vcu * 8 + wave, NGW = G * 8;
    unsigned char* ws = p.ws;
    constexpr int I_IN = 16 * 72, I_SQ = 16 * 32, I_1 = 16 * 128, I_2 = 64 * 32, I_C1 = 32 * 8, I_C2 = 4 * 8, I_PW = 4 * 8;
    constexpr int PER_L = I_IN + 5 * I_SQ + I_1 + I_2 + 2 * I_C1 + 2 * I_C2 + I_PW;
    for (int it = gw; it < 2 * PER_L; it += NGW) {
        const int l = it / PER_L; int r = it % PER_L; unsigned char* wl = ws + WS_W + (size_t)l * WS_WL;
        if (r < I_IN) { tr_item(p.in[I_WIN] + (size_t)l * DM * 2072, DM, 2072, DINP, (bf16_t*)(wl + W_IN), scr, r, lane); continue; } r -= I_IN;
        if (r < I_SQ) { tr_item(p.in[I_WOUT] + (size_t)l * DM * DM, DM, DM, DM, (bf16_t*)(wl + W_OUT), scr, r, lane); continue; } r -= I_SQ;
        if (r < I_SQ) { tr_item(p.in[I_WQ] + (size_t)l * DM * DM, DM, DM, DM, (bf16_t*)(wl + W_Q), scr, r, lane); continue; } r -= I_SQ;
        if (r < I_SQ) { tr_item(p.in[I_WO] + (size_t)l * DM * DM, DM, DM, DM, (bf16_t*)(wl + W_O), scr, r, lane); continue; } r -= I_SQ;
        if (r < I_SQ) { tr_item(p.in[I_WK] + (size_t)l * DM * DM, DM, DM, DM, (bf16_t*)(wl + W_K), scr, r, lane); continue; } r -= I_SQ;
        if (r < I_SQ) { tr_item(p.in[I_WV] + (size_t)l * DM * DM, DM, DM, DM, (bf16_t*)(wl + W_V), scr, r, lane); continue; } r -= I_SQ;
        if (r < I_1) { tr_item(p.in[I_W1] + (size_t)l * DM * FF, DM, FF, FF, (bf16_t*)(wl + W_1), scr, r, lane); continue; } r -= I_1;
        if (r < I_2) { tr_item(p.in[I_W2] + (size_t)l * FF * DM, FF, DM, DM, (bf16_t*)(wl + W_2), scr, r, lane); continue; } r -= I_2;
        if (r < I_C1) { tr_item(p.in[I_CKW1] + (size_t)l * 2048 * 256, 2048, 256, 256, (bf16_t*)(wl + W_CK1), scr, r, lane); continue; } r -= I_C1;
        if (r < I_C1) { tr_item(p.in[I_CVW1] + (size_t)l * 2048 * 256, 2048, 256, 256, (bf16_t*)(wl + W_CV1), scr, r, lane); continue; } r -= I_C1;
        if (r < I_C2) { tr_item(p.in[I_CKW2] + (size_t)l * 256 * 64, 256, 64, 256, (bf16_t*)(wl + W_CK2), scr, r, lane); continue; } r -= I_C2;
        if (r < I_C2) { tr_item(p.in[I_CVW2] + (size_t)l * 256 * 64, 256, 64, 256, (bf16_t*)(wl + W_CV2), scr, r, lane); continue; } r -= I_C2;
        tr_item(p.in[I_CPW] + (size_t)l * 256 * 256, 256, 256, 256, (bf16_t*)(wl + W_CPW), scr, r, lane);
    }
    for (int e = vcu * 512 + tid; e < 2 * 65536; e += G * 512) {
        const int l = e >> 16, n = (e >> 8) & 255, k = e & 255;
        float v = 0.f;
        if ((n >> 6) == (k >> 6)) v = p.in[I_POOLW][(size_t)l * 16384 + (n >> 6) * 4096 + (k & 63) * 64 + (n & 63)] * p.in[I_POOLS][l * 256 + n];
        ((bf16_t*)(ws + WS_W + (size_t)l * WS_WL + W_POOL))[n * 256 + k] = (bf16_t)f2bf(v);
    }
    for (int it = vcu; it < 16; it += G) {
        const int l = it >> 3, kv = (it >> 2) & 1, nc = it & 3;
        const float* pos = p.in[kv ? I_CVPOS : I_CKPOS] + (size_t)l * 2048;
        const float* w1 = p.in[kv ? I_CVW1 : I_CKW1] + (size_t)l * 2048 * 256;
        const int ks = tid >> 6, n = nc * 64 + (tid & 63);
        float a = 0.f;
        for (int k = ks * 256; k < ks * 256 + 256; ++k) a += pos[k] * w1[(size_t)k * 256 + n];
        LAS float* red = (LAS float*)(lds + 131072);
        red[ks * 64 + (tid & 63)] = a;
        __syncthreads();
        if (tid < 64) { float s = 0.f;
#pragma unroll
            for (int q = 0; q < 8; ++q) s += red[q * 64 + tid];
            ((float*)(ws + WS_W + (size_t)l * WS_WL + (kv ? W_CB1V : W_CB1K)))[nc * 64 + tid] = s; }
        __syncthreads();
    }
    for (int m = gw; m < 2 * NB * NMEM; m += NGW) { const int l = m / (NB * NMEM), r = m % (NB * NMEM);
        rms_row_to_bf16(p.in[I_MEM] + (size_t)r * DM, p.in[I_MEMG] + l * DM, (bf16_t*)(ws + WS_W + (size_t)l * WS_WL + W_MEMN) + (size_t)r * DM, lane); }
    for (int m = gw; m < MTOK; m += NGW) rms_row_to_bf16(p.in[I_X] + (size_t)m * DM, p.in[I_MIXPRE], (bf16_t*)(ws + WS_XN) + (size_t)m * DM, lane);
}

__device__ __forceinline__ void rowwise_phase(const float* xsrc, float* xdst, const bf16_t* mix, const float* gpost, const float* gnext, bf16_t* xn, int vcu, int G) {
    const int tid = opaque_tid(), lane = tid & 63, wave = tid >> 6;
    const int gw = vcu * 8 + wave, NGW = G * 8;
    f32x4 xa[4]; u32x2 ma[4];
    if (gw < MTOK) {
#pragma unroll
        for (int j = 0; j < 4; ++j) { xa[j] = ((const f32x4*)(xsrc + (size_t)gw * DM))[lane + 64 * j]; ma[j] = ((const u32x2*)(mix + (size_t)gw * DM))[lane + 64 * j]; }
    }
    for (int m = gw; m < MTOK; m += NGW) {
        f32x4 xb[4]; u32x2 mb[4]; const int mn = m + NGW;
        if (mn < MTOK) {
#pragma unroll
            for (int j = 0; j < 4; ++j) { xb[j] = ((const f32x4*)(xsrc + (size_t)mn * DM))[lane + 64 * j]; mb[j] = ((const u32x2*)(mix + (size_t)mn * DM))[lane + 64 * j]; }
        } else {
#pragma unroll
            for (int j = 0; j < 4; ++j) { xb[j] = xa[j]; mb[j] = ma[j]; }
        }
        f32x4 y[4], x[4]; float s = 0.f;
#pragma unroll
        for (int j = 0; j < 4; ++j) { const u32x2 w = ma[j]; x[j] = xa[j];
            y[j].x = __builtin_bit_cast(float, w.x << 16); y[j].y = __builtin_bit_cast(float, w.x & 0xffff0000u); y[j].z = __builtin_bit_cast(float, w.y << 16); y[j].w = __builtin_bit_cast(float, w.y & 0xffff0000u);
            s += (y[j].x * y[j].x + y[j].y * y[j].y) + (y[j].z * y[j].z + y[j].w * y[j].w); }
        const float rstd = 1.f / sqrtf(wave_sum(s) * (1.f / DM) + EPS);
        float s2 = 0.f;
#pragma unroll
        for (int j = 0; j < 4; ++j) { const f32x4 gg = ((const f32x4*)gpost)[lane + 64 * j]; x[j] = x[j] + y[j] * rstd * gg;
            s2 += (x[j].x * x[j].x + x[j].y * x[j].y) + (x[j].z * x[j].z + x[j].w * x[j].w);
            ((f32x4*)(xdst + (size_t)m * DM))[lane + 64 * j] = x[j]; }
        if (gnext) {
            const float r2 = 1.f / sqrtf(wave_sum(s2) * (1.f / DM) + EPS);
            u32x2* o8 = (u32x2*)(xn + (size_t)m * DM) + lane;
#pragma unroll
            for (int j = 0; j < 4; ++j) { const f32x4 gg = ((const f32x4*)gnext)[lane + 64 * j]; u32x2 w; w.x = pk2(x[j].x * r2 * gg.x, x[j].y * r2 * gg.y); w.y = pk2(x[j].z * r2 * gg.z, x[j].w * r2 * gg.w); o8[64 * j] = w; }
        }
#pragma unroll
        for (int j = 0; j < 4; ++j) { xa[j] = xb[j]; ma[j] = mb[j]; }
    }
}

__device__ __forceinline__ void prep_phase(const Params& p, int l, LAS unsigned char* lds, int vcu, int G) {
    const int tid = opaque_tid(), lane = tid & 63, wave = tid >> 6;
    const bf16_t* PROJ = (const bf16_t*)(p.ws + WS_PROJ); bf16_t* ACT = (bf16_t*)(p.ws + WS_ACT);
    bf16_t* KCR = (bf16_t*)(p.ws + WS_KCRAW); bf16_t* VCR = (bf16_t*)(p.ws + WS_VCRAW);
    LAS bf16_t* hT = (LAS bf16_t*)lds;
    LAS float* cv = (LAS float*)(lds + 49152);
    const float* cw = p.in[I_CONVW] + (size_t)l * 31 * 256; const float* cb = p.in[I_CONVB] + l * 256;
    const float* lg = p.in[I_CLNG] + l * 256; const float* lb = p.in[I_CLNB] + l * 256;
    for (int u = vcu; u < MTOK / 64; u += G) {
        const int b = u >> 7, t0 = (u & 127) * 64; const size_t R0 = (size_t)b * SEQ + t0;
        for (int it = tid; it < 94 * 32; it += 512) { const int jr = it >> 5, ch = (it & 31) * 8; const int t = t0 - 30 + jr;
            u32x4 o = (u32x4){0u, 0u, 0u, 0u};
            if (t >= 0) { const bf16_t* rp = PROJ + ((size_t)b * SEQ + t) * DINP; const u32x4 a = *(const u32x4*)(rp + 256 + ch), gt = *(const u32x4*)(rp + 512 + ch);
#pragma unroll
                for (int e = 0; e < 4; ++e) { const unsigned aw = a[e], gw_ = gt[e];
                    const float a0 = __builtin_bit_cast(float, aw << 16), a1 = __builtin_bit_cast(float, aw & 0xffff0000u), g0 = __builtin_bit_cast(float, gw_ << 16), g1 = __builtin_bit_cast(float, gw_ & 0xffff0000u);
                    o[e] = pk2(a0 / (1.f + __expf(-g0)), a1 / (1.f + __expf(-g1))); } }
            *(LAS u32x4*)(hT + jr * 256 + ch) = o; }
        { const int c = tid & 255, half = tid >> 8; const int w = 2 << (c >> 6);
          const bf16_t* up = PROJ + (size_t)b * SEQ * DINP + c;
          float sum = 0.f; const int ts = t0 + half * 32;
          for (int d = 1; d < w; ++d) { const int t = ts - d; if (t >= 0) sum += bf2f(up[(size_t)t * DINP]); }
          for (int i = 0; i < 32; ++i) { const int t = ts + i; const float ut = bf2f(up[(size_t)t * DINP]); sum += ut;
              const int cnt = (t + 1 < w) ? (t + 1) : w; const float d = sum / (float)cnt - ut;
              ACT[((size_t)b * SEQ + t) * 512 + c] = (bf16_t)f2bf(d);
              const int tb = t - w + 1; if (tb >= 0) sum -= bf2f(up[(size_t)tb * DINP]); } }
        for (int it = tid; it < 64 * 32; it += 512) { const int i = it >> 5, cc = it & 31; const int which = cc >> 4, g = (cc >> 3) & 1, d8 = (cc & 7) * 8;
            const u32x4 v = *(const u32x4*)(PROJ + (R0 + i) * DINP + 1280 + cc * 8);
            bf16_t* dst = (which ? VCR : KCR) + (((size_t)(b * 2 + g) * SEQ + t0 + i) * 64 + d8); *(u32x4*)dst = v; }
        __syncthreads();
        { const int c = tid & 255, half = tid >> 8; float wv[31];
#pragma unroll
          for (int k = 0; k < 31; ++k) wv[k] = cw[k * 256 + c];
          const float bias = cb[c];
          for (int i = half * 32; i < half * 32 + 32; ++i) { float a = bias;
#pragma unroll
              for (int k = 0; k < 31; ++k) a += wv[k] * bf2f(hT[(i + k) * 256 + c]);
              cv[i * 256 + c] = a; } }
        __syncthreads();
        for (int i = wave * 8; i < wave * 8 + 8; ++i) { const f32x4 x = *(LAS f32x4*)(cv + i * 256 + lane * 4);
            const float mu = wave_sum((x.x + x.y) + (x.z + x.w)) * (1.f / 256.f);
            const f32x4 dd = x - mu; const float var = wave_sum((dd.x * dd.x + dd.y * dd.y) + (dd.z * dd.z + dd.w * dd.w)) * (1.f / 256.f);
            const float rs = 1.f / sqrtf(var + EPS); const f32x4 gg = *(const f32x4*)(lg + lane * 4), bb = *(const f32x4*)(lb + lane * 4);
            f32x4 y = dd * rs * gg + bb;
#pragma unroll
            for (int e = 0; e < 4; ++e) y[e] = y[e] / (1.f + __expf(-y[e]));
            u32x2 w; w.x = pk2(y.x, y.y); w.y = pk2(y.z, y.w);
            *(u32x2*)(ACT + (R0 + i) * 512 + 256 + lane * 4) = w; }
        __syncthreads();
    }
}

namespace nsa {
constexpr int KB0 = 0, VB0 = 24576, LUT_OFF = 49152, WSF_OFF = 51712, SEL_OFF = 52736, IMP_OFF = 53760, OST_OFF = 87040, IMP_PITCH = 129, LUT_PITCH = 132;
__device__ __forceinline__ int crow(int r, int hi) { return (r & 3) + 8 * (r >> 2) + 4 * hi; }
__device__ __forceinline__ int rel_bucket_dev(int n) {
    if (n < 16) return n;
    const float v = logf((float)n / 16.f) / 2.0794415416798357f * 16.f;
    const int b = 16 + (int)v; return b < 31 ? b : 31;
}
__device__ __forceinline__ s16x4 vtr(LAS const char* p) { return __builtin_bit_cast(s16x4, __builtin_amdgcn_ds_read_tr16_b64_v4i16((LAS s16x4*)p)); }

struct TileRegs { u32x4 k, v; };
__device__ __forceinline__ void gload(TileRegs& R, const bf16_t* Kg, const bf16_t* Vg, int pitch, int tile, int wid, int lane) {
    const char* kt = (const char*)(Kg + (size_t)tile * 64 * pitch); const char* vt = (const char*)(Vg + (size_t)tile * 64 * pitch);
    const unsigned ko = (unsigned)(lane * pitch + wid * 8) * 2u;
    const unsigned vo = (unsigned)((16 * (wid & 3) + (lane >> 2)) * pitch + (wid >> 2) * 32 + (lane & 3) * 8) * 2u;
    R.k = *(const u32x4*)(kt + ko);
    R.v = *(const u32x4*)(vt + vo);
}
__device__ __forceinline__ void lstore(const TileRegs& R, LAS unsigned char* lds, int buf, int wid, int lane) {
    *(LAS u32x4*)(lds + KB0 + buf * 8192 + wid * 1024 + lane * 16) = R.k;
    *(LAS u32x4*)(lds + VB0 + buf * 8192 + wid * 1024 + lane * 16) = R.v;
}

template <int BR>
__device__ __forceinline__ void tile_compute(LAS unsigned char* lds, int buf, const bf16x8 (&qr)[4], f32x16 (&o)[2], float& m, float& l, float linv,
                                             int Dbase, bool general, float farb, LAS const float* lutr, bool rowvalid, int tok, int mbase, float& carry, int lane, int wid) {
    const int r32 = lane & 31, hi = lane >> 5;
    constexpr int KS = (BR <= 1) ? 16 : 1;
    f32x16 p0 = {}, p1 = {};
    { LAS const char* kb = (LAS const char*)(lds + KB0 + buf * 8192 + hi * 1024 + r32 * 16);
#pragma unroll
      for (int d0 = 0; d0 < 4; ++d0) { const bf16x8 b0 = *(LAS const bf16x8*)(kb + d0 * 2048), b1 = *(LAS const bf16x8*)(kb + d0 * 2048 + 512);
          p0 = __builtin_amdgcn_mfma_f32_32x32x16_bf16(b0, qr[d0], p0, 0, 0, 0); p1 = __builtin_amdgcn_mfma_f32_32x32x16_bf16(b1, qr[d0], p1, 0, 0, 0); } }
    if (general) {
#pragma unroll
        for (int r = 0; r < 16; ++r) { const int kv = crow(r, hi); const int d0 = Dbase - KS * kv, d1 = d0 - KS * 32;
            bool v0 = d0 >= 0 && rowvalid, v1 = d1 >= 0 && rowvalid; if (BR == 3) { v0 = v0 && d0 < 512; v1 = v1 && d1 < 512; }
            const int i0 = d0 < 0 ? 0 : (d0 > 128 ? 128 : d0), i1 = d1 < 0 ? 0 : (d1 > 128 ? 128 : d1);
            p0[r] = v0 ? p0[r] + lutr[i0] : NEGV; p1[r] = v1 ? p1[r] + lutr[i1] : NEGV; }
    } else {
#pragma unroll
        for (int r = 0; r < 16; ++r) { p0[r] = rowvalid ? p0[r] + farb : NEGV; p1[r] = rowvalid ? p1[r] + farb : NEGV; }
    }
    if (BR == 1) {
#pragma unroll
        for (int r = 0; r < 16; ++r) { p0[r] = ex2(p0[r] - m) * linv; p1[r] = ex2(p1[r] - m) * linv; }
        LAS float* IMP = (LAS float*)(lds + IMP_OFF) + tok * IMP_PITCH;
        float px[4], py[4];
#pragma unroll
        for (int k = 0; k < 4; ++k) { px[k] = __shfl_xor(p0[4 * k + 3], 32); py[k] = __shfl_xor(p1[4 * k + 3], 32); }
#pragma unroll
        for (int k = 0; k < 4; ++k) {
            const float pv0 = hi ? px[k] : (k == 0 ? carry : px[k > 0 ? k - 1 : 0]);
            const float pv1 = hi ? py[k] : (k == 0 ? px[3] : py[k > 0 ? k - 1 : 0]);
            float g0 = (p0[4 * k] + p0[4 * k + 1]) + (p0[4 * k + 2] + p0[4 * k + 3]) + pv0;
            float g1 = (p1[4 * k] + p1[4 * k + 1]) + (p1[4 * k + 2] + p1[4 * k + 3]) + pv1;
            g0 += __shfl_xor(g0, 1); g0 += __shfl_xor(g0, 2); g1 += __shfl_xor(g1, 1); g1 += __shfl_xor(g1, 2);
            if ((r32 & 3) == 0) { const int mi = mbase + 2 * k + hi; IMP[mi] = g0; IMP[mi + 8] = g1; }
        }
        carry = py[3];
    } else {
        float mx = NEGV;
#pragma unroll
        for (int r = 0; r < 16; ++r) mx = fmaxf(mx, fmaxf(p0[r], p1[r]));
        mx = fmaxf(mx, __shfl_xor(mx, 32));
        const float mn = fmaxf(m, mx); const float alpha = ex2(m - mn); m = mn;
        float sm = 0.f;
#pragma unroll
        for (int r = 0; r < 16; ++r) { p0[r] = ex2(p0[r] - mn); p1[r] = ex2(p1[r] - mn); sm += p0[r] + p1[r]; }
        l = l * alpha + sm;
        if (BR >= 2) {
            if (__any(alpha != 1.f)) {
                LAS float* wsf = (LAS float*)(lds + WSF_OFF) + wid * 32;
                if (hi == 0) wsf[r32] = alpha;
                asm volatile("s_waitcnt lgkmcnt(0)" ::: "memory");
#pragma unroll
                for (int r = 0; r < 16; ++r) { const float a = wsf[crow(r, hi)]; o[0][r] *= a; o[1][r] *= a; }
                asm volatile("s_waitcnt lgkmcnt(0)" ::: "memory");
            }
        }
    }
    if (BR >= 1) {
        u32x4 pw[4];
        pw[0] = (u32x4){cvt_pk_bf16(p0[0], p0[1]), cvt_pk_bf16(p0[2], p0[3]), cvt_pk_bf16(p0[4], p0[5]), cvt_pk_bf16(p0[6], p0[7])};
        pw[1] = (u32x4){cvt_pk_bf16(p0[8], p0[9]), cvt_pk_bf16(p0[10], p0[11]), cvt_pk_bf16(p0[12], p0[13]), cvt_pk_bf16(p0[14], p0[15])};
        pw[2] = (u32x4){cvt_pk_bf16(p1[0], p1[1]), cvt_pk_bf16(p1[2], p1[3]), cvt_pk_bf16(p1[4], p1[5]), cvt_pk_bf16(p1[6], p1[7])};
        pw[3] = (u32x4){cvt_pk_bf16(p1[8], p1[9]), cvt_pk_bf16(p1[10], p1[11]), cvt_pk_bf16(p1[12], p1[13]), cvt_pk_bf16(p1[14], p1[15])};
        LAS const char* vp = (LAS const char*)(lds + VB0 + buf * 8192 + ((lane >> 4) & 1) * 32 + (lane & 3) * 8 + (4 * hi + ((lane & 15) >> 2)) * 64);
#pragma unroll
        for (int d0 = 0; d0 < 2; ++d0)
#pragma unroll
            for (int ks = 0; ks < 4; ++ks) { const s16x4 lo = vtr(vp + d0 * 4096 + ks * 1024), hh = vtr(vp + d0 * 4096 + ks * 1024 + 512);
                const bf16x8 vf = (bf16x8){lo[0], lo[1], lo[2], lo[3], hh[0], hh[1], hh[2], hh[3]};
                o[d0] = __builtin_amdgcn_mfma_f32_32x32x16_bf16(__builtin_bit_cast(bf16x8, pw[ks]), vf, o[d0], 0, 0, 0); }
    }
}

__device__ __forceinline__ void accum_branch(LAS unsigned char* lds, f32x16 (&o)[2], float fac, bool first, int lane, int wid) {
    const int r32 = lane & 31, hi = lane >> 5;
    LAS float* wsf = (LAS float*)(lds + WSF_OFF) + wid * 32;
    LAS float* st = (LAS float*)(lds + OST_OFF) + wid * 2048 + lane;
    if (hi == 0) wsf[r32] = fac;
    asm volatile("s_waitcnt lgkmcnt(0)" ::: "memory");
#pragma unroll
    for (int r = 0; r < 16; ++r) { const float a = wsf[crow(r, hi)];
        float v0 = o[0][r] * a, v1 = o[1][r] * a;
        if (!first) { v0 += st[(r * 2) * 64]; v1 += st[(r * 2 + 1) * 64]; }
        st[(r * 2) * 64] = v0; st[(r * 2 + 1) * 64] = v1; }
    asm volatile("s_waitcnt lgkmcnt(0)" ::: "memory");
}

__device__ __forceinline__ void qk_tile(LAS unsigned char* lds, int slot, const bf16x8 (&qr)[4], float ci, f32x16& p0, f32x16& p1, int r32, int hi) {
#pragma unroll
    for (int r = 0; r < 16; ++r) { p0[r] = ci; p1[r] = ci; }
    LAS const char* kb = (LAS const char*)(lds + KB0 + slot * 8192 + hi * 1024 + r32 * 16);
#pragma unroll
    for (int d0 = 0; d0 < 4; ++d0) { const bf16x8 b0 = *(LAS const bf16x8*)(kb + d0 * 2048), b1 = *(LAS const bf16x8*)(kb + d0 * 2048 + 512);
        p0 = __builtin_amdgcn_mfma_f32_32x32x16_bf16(b0, qr[d0], p0, 0, 0, 0); p1 = __builtin_amdgcn_mfma_f32_32x32x16_bf16(b1, qr[d0], p1, 0, 0, 0); }
}
__device__ __forceinline__ unsigned pkbf(float lo, float hi) { typedef __bf16 bf2 __attribute__((ext_vector_type(2))); f32x2 v = {lo, hi}; return __builtin_bit_cast(unsigned, __builtin_convertvector(v, bf2)); }
__device__ __forceinline__ void pv_tile(LAS unsigned char* lds, int slot, const f32x16& p0, const f32x16& p1, f32x16 (&o)[2], int lane, int hi) {
    u32x4 pw[4];
    pw[0] = (u32x4){pkbf(p0[0], p0[1]), pkbf(p0[2], p0[3]), pkbf(p0[4], p0[5]), pkbf(p0[6], p0[7])};
    pw[1] = (u32x4){pkbf(p0[8], p0[9]), pkbf(p0[10], p0[11]), pkbf(p0[12], p0[13]), pkbf(p0[14], p0[15])};
    pw[2] = (u32x4){pkbf(p1[0], p1[1]), pkbf(p1[2], p1[3]), pkbf(p1[4], p1[5]), pkbf(p1[6], p1[7])};
    pw[3] = (u32x4){pkbf(p1[8], p1[9]), pkbf(p1[10], p1[11]), pkbf(p1[12], p1[13]), pkbf(p1[14], p1[15])};
    LAS const char* vp = (LAS const char*)(lds + VB0 + slot * 8192 + ((lane >> 4) & 1) * 32 + (lane & 3) * 8 + (4 * hi + ((lane & 15) >> 2)) * 64);
    __builtin_amdgcn_sched_barrier(0);
#pragma unroll
    for (int d0 = 0; d0 < 2; ++d0) {
#pragma unroll
        for (int ks = 0; ks < 4; ++ks) { const s16x4 lo = vtr(vp + d0 * 4096 + ks * 1024), hh = vtr(vp + d0 * 4096 + ks * 1024 + 512);
            const bf16x8 vf = (bf16x8){lo[0], lo[1], lo[2], lo[3], hh[0], hh[1], hh[2], hh[3]};
            o[d0] = __builtin_amdgcn_mfma_f32_32x32x16_bf16(__builtin_bit_cast(bf16x8, pw[ks]), vf, o[d0], 0, 0, 0); }
        __builtin_amdgcn_sched_barrier(0);
    }
}
template <int BR>
__device__ __forceinline__ void pipe_step(LAS unsigned char* lds, int k, int n, int qt, int slot_c, int slot_n, bool act_c, bool& act_n,
                                          f32x16& sc0, f32x16& sc1, f32x16& sn0, f32x16& sn1, const bf16x8 (&qr)[4], f32x16 (&o)[2], float& mref, float& l,
                                          LAS const float* lutr, float farb, LAS const unsigned* selw, LAS float* wsf, int tok, int lane) {
    const int r32 = lane & 31, hi = lane >> 5;
    const int tile = qt - k;
    float ci = 0.f; act_n = false;
    if (k + 1 < n) {
        const int tn = tile - 1, dn = k + 1;
        const bool gen_n = dn <= 2 || (BR == 3 && dn >= 8);
        bool rv = true; if (BR == 2) rv = (selw[tn >> 5] >> (tn & 31)) & 1u;
        act_n = (BR == 3) || __any(rv);
        ci = (gen_n ? 0.f : (rv ? farb : NEGV)) - mref;
    }
    if (act_n) {
        bf16x8 kf[8];
        LAS const char* kb = (LAS const char*)(lds + KB0 + slot_n * 8192 + hi * 1024 + r32 * 16);
#pragma unroll
        for (int d0 = 0; d0 < 4; ++d0) { kf[2 * d0] = *(LAS const bf16x8*)(kb + d0 * 2048); kf[2 * d0 + 1] = *(LAS const bf16x8*)(kb + d0 * 2048 + 512); }
#pragma unroll
        for (int r = 0; r < 16; ++r) { sn0[r] = ci; sn1[r] = ci; }
        __builtin_amdgcn_sched_barrier(0);
#pragma unroll
        for (int i = 0; i < 8; ++i) {
            if (i & 1) sn1 = __builtin_amdgcn_mfma_f32_32x32x16_bf16(kf[i], qr[i >> 1], sn1, 0, 0, 0);
            else       sn0 = __builtin_amdgcn_mfma_f32_32x32x16_bf16(kf[i], qr[i >> 1], sn0, 0, 0, 0); }
    } else {
#pragma unroll
        for (int r = 0; r < 16; ++r) { sn0[r] = 0.f; sn1[r] = 0.f; }
    }
    if (act_c) {
        const bool gen = k <= 2 || (BR == 3 && k >= 8);
        if (gen) {
            bool rv = true; if (BR == 2) rv = (selw[tile >> 5] >> (tile & 31)) & 1u;
            const int Dbase = 64 * k + tok;
#pragma unroll
            for (int r = 0; r < 16; ++r) { const int kv = crow(r, hi); const int d0 = Dbase - kv, d1 = d0 - 32;
                bool v0 = d0 >= 0 && rv, v1 = d1 >= 0 && rv; if (BR == 3) { v0 = v0 && d0 < 512; v1 = v1 && d1 < 512; }
                const int i0 = d0 < 0 ? 0 : (d0 > 128 ? 128 : d0), i1 = d1 < 0 ? 0 : (d1 > 128 ? 128 : d1);
                sc0[r] = v0 ? sc0[r] + lutr[i0] : NEGV; sc1[r] = v1 ? sc1[r] + lutr[i1] : NEGV; }
        }
        LAS const char* vp = (LAS const char*)(lds + VB0 + slot_c * 8192 + ((lane >> 4) & 1) * 32 + (lane & 3) * 8 + (4 * hi + ((lane & 15) >> 2)) * 64);
        s16x4 va[4], vb[4];
#pragma unroll
        for (int ks = 0; ks < 4; ++ks) { va[ks] = vtr(vp + ks * 1024); vb[ks] = vtr(vp + ks * 1024 + 512); }
        float rm = fmaxf(fmaxf(sc0[0], sc0[1]), sc1[0]);
        { float rb = fmaxf(fmaxf(sc0[2], sc0[3]), sc1[1]); rm = fmaxf(fmaxf(rm, sc1[2]), sc1[3]);
#pragma unroll
          for (int r = 4; r < 16; r += 4) { rm = fmaxf(fmaxf(rm, sc0[r]), sc0[r + 1]); rb = fmaxf(fmaxf(rb, sc0[r + 2]), sc0[r + 3]); rm = fmaxf(fmaxf(rm, sc1[r]), sc1[r + 1]); rb = fmaxf(fmaxf(rb, sc1[r + 2]), sc1[r + 3]); }
          rm = fmaxf(rm, rb); }
        rm = fmaxf(rm, __shfl_xor(rm, 32));
        const bool need = (k == 0) || rm > 8.f;
        if (__any(need)) {
            const float dl = need ? rm : 0.f;
            mref += dl;
#pragma unroll
            for (int r = 0; r < 16; ++r) { sc0[r] -= dl; sc1[r] -= dl; }
            if (act_n) {
#pragma unroll
                for (int r = 0; r < 16; ++r) { sn0[r] -= dl; sn1[r] -= dl; }
            }
            const float alpha = ex2(-dl); l *= alpha;
            if (hi == 0) wsf[r32] = alpha;
            asm volatile("s_waitcnt lgkmcnt(0)" ::: "memory");
#pragma unroll
            for (int r = 0; r < 16; ++r) { const float a = wsf[crow(r, hi)]; o[0][r] *= a; o[1][r] *= a; }
            asm volatile("s_waitcnt lgkmcnt(0)" ::: "memory");
        }
        float sm0 = 0.f, sm1 = 0.f;
#pragma unroll
        for (int r = 0; r < 16; r += 2) { sc0[r] = ex2(sc0[r]); sc0[r + 1] = ex2(sc0[r + 1]); sc1[r] = ex2(sc1[r]); sc1[r + 1] = ex2(sc1[r + 1]); sm0 += sc0[r] + sc0[r + 1]; sm1 += sc1[r] + sc1[r + 1]; }
        l += sm0 + sm1;
        u32x4 pw[4];
        pw[0] = (u32x4){pkbf(sc0[0], sc0[1]), pkbf(sc0[2], sc0[3]), pkbf(sc0[4], sc0[5]), pkbf(sc0[6], sc0[7])};
        pw[1] = (u32x4){pkbf(sc0[8], sc0[9]), pkbf(sc0[10], sc0[11]), pkbf(sc0[12], sc0[13]), pkbf(sc0[14], sc0[15])};
        pw[2] = (u32x4){pkbf(sc1[0], sc1[1]), pkbf(sc1[2], sc1[3]), pkbf(sc1[4], sc1[5]), pkbf(sc1[6], sc1[7])};
        pw[3] = (u32x4){pkbf(sc1[8], sc1[9]), pkbf(sc1[10], sc1[11]), pkbf(sc1[12], sc1[13]), pkbf(sc1[14], sc1[15])};
        __builtin_amdgcn_sched_barrier(0);
        s16x4 vc[4], vd[4];
#pragma unroll
        for (int ks = 0; ks < 4; ++ks) { vc[ks] = vtr(vp + 4096 + ks * 1024); vd[ks] = vtr(vp + 4096 + ks * 1024 + 512); }
#pragma unroll
        for (int ks = 0; ks < 4; ++ks) { const bf16x8 vf = (bf16x8){va[ks][0], va[ks][1], va[ks][2], va[ks][3], vb[ks][0], vb[ks][1], vb[ks][2], vb[ks][3]};
            o[0] = __builtin_amdgcn_mfma_f32_32x32x16_bf16(__builtin_bit_cast(bf16x8, pw[ks]), vf, o[0], 0, 0, 0); }
        __builtin_amdgcn_sched_barrier(0);
#pragma unroll
        for (int ks = 0; ks < 4; ++ks) { const bf16x8 vf = (bf16x8){vc[ks][0], vc[ks][1], vc[ks][2], vc[ks][3], vd[ks][0], vd[ks][1], vd[ks][2], vd[ks][3]};
            o[1] = __builtin_amdgcn_mfma_f32_32x32x16_bf16(__builtin_bit_cast(bf16x8, pw[ks]), vf, o[1], 0, 0, 0); }
    }
}
template <int BR>
__device__ __forceinline__ void run_pipe(LAS unsigned char* lds, const bf16_t* Kg, const bf16_t* Vg, int n, const bf16x8 (&qr)[4], f32x16 (&o)[2], float& lout,
                                         int qt, int tok, int head, int lane, int wid) {
    const int r32 = lane & 31, hi = lane >> 5;
    LAS const float* lutr = (LAS const float*)(lds + LUT_OFF) + head * LUT_PITCH;
    const float farb = lutr[128];
    LAS const unsigned* selw = (LAS const unsigned*)(lds + SEL_OFF) + tok * 4;
    LAS float* wsf = (LAS float*)(lds + WSF_OFF) + wid * 32;
    TileRegs R;
    gload(R, Kg, Vg, DINP, qt, wid, lane); lstore(R, lds, 0, wid, lane);
    if (n > 1) { gload(R, Kg, Vg, DINP, qt - 1, wid, lane); lstore(R, lds, 1, wid, lane); }
    if (n > 2) gload(R, Kg, Vg, DINP, qt - 2, wid, lane);
    __syncthreads();
    float mref = 0.f, l = 0.f;
    f32x16 sa0, sa1, sb0, sb1;
    qk_tile(lds, 0, qr, 0.f, sa0, sa1, r32, hi);
    sb0 = sa0; sb1 = sa1;
    bool act_c = true; int slot_c = 0;
    for (int k = 0; k < n; k += 2) {
        bool act_n;
        int slot_n = slot_c == 2 ? 0 : slot_c + 1;
        pipe_step<BR>(lds, k, n, qt, slot_c, slot_n, act_c, act_n, sa0, sa1, sb0, sb1, qr, o, mref, l, lutr, farb, selw, wsf, tok, lane);
        if (k + 2 < n) lstore(R, lds, slot_n == 2 ? 0 : slot_n + 1, wid, lane);
        if (k + 3 < n) gload(R, Kg, Vg, DINP, qt - k - 3, wid, lane);
        __syncthreads();
        act_c = act_n; slot_c = slot_n;
        if (k + 1 >= n) break;
        slot_n = slot_c == 2 ? 0 : slot_c + 1;
        pipe_step<BR>(lds, k + 1, n, qt, slot_c, slot_n, act_c, act_n, sb0, sb1, sa0, sa1, qr, o, mref, l, lutr, farb, selw, wsf, tok, lane);
        if (k + 3 < n) lstore(R, lds, slot_n == 2 ? 0 : slot_n + 1, wid, lane);
        if (k + 4 < n) gload(R, Kg, Vg, DINP, qt - k - 4, wid, lane);
        __syncthreads();
        act_c = act_n; slot_c = slot_n;
    }
    lout = l;
}

template <int BR>
__device__ __forceinline__ void run_branch(LAS unsigned char* lds, const bf16_t* Kg, const bf16_t* Vg, int pitch, int first, int step, int n,
                                           const bf16x8 (&qr)[4], f32x16 (&o)[2], float& m, float& l, float linv,
                                           int t0, int qt, int tok, int head, int lane, int wid) {
    TileRegs R; float carry = 0.f;
    gload(R, Kg, Vg, pitch, first, wid, lane); lstore(R, lds, 0, wid, lane);
    __syncthreads();
    LAS const float* lutr = (LAS const float*)(lds + LUT_OFF) + head * LUT_PITCH;
    const float farb = lutr[128];
    LAS const unsigned* selw = (LAS const unsigned*)(lds + SEL_OFF) + tok * 4;
    for (int k = 0; k < n; ++k) {
        const int tile = first + k * step;
        if (k + 1 < n) gload(R, Kg, Vg, pitch, tile + step, wid, lane);
        int Dbase; bool general; bool rowvalid = true;
        if (BR <= 1) { Dbase = t0 + tok - 31 - 16 * 64 * tile; general = (t0 - 16 * (64 * tile + 63) - 31) < 128; }
        else { Dbase = 64 * (qt - tile) + tok; general = (qt - tile) <= 2 || (BR == 3 && (qt - tile) >= 8); }
        if (BR == 2) rowvalid = (selw[tile >> 5] >> (tile & 31)) & 1u;
        if (BR != 2 || __any(rowvalid))
            tile_compute<BR>(lds, k & 1, qr, o, m, l, linv, Dbase, general, farb, lutr, rowvalid, tok, tile * 16, carry, lane, wid);
        if (k + 1 < n) lstore(R, lds, (k + 1) & 1, wid, lane);
        __syncthreads();
    }
}

__device__ __forceinline__ void nsa_unit(const Params& p, int l, LAS unsigned char* lds, int b, int g, int qt) {
    const int tid = opaque_tid(), lane = tid & 63, wid = __builtin_amdgcn_readfirstlane(tid >> 6), r32 = lane & 31, hi = lane >> 5;
    const bf16_t* PROJ = (const bf16_t*)(p.ws + WS_PROJ);
    const bf16_t* KC = (const bf16_t*)(p.ws + WS_KC) + (size_t)(b * 2 + g) * 512 * 256;
    const bf16_t* VC = (const bf16_t*)(p.ws + WS_VC) + (size_t)(b * 2 + g) * 512 * 256;
    bf16_t* CAT = (bf16_t*)(p.ws + WS_CAT);
    const int t0 = qt * 64; const size_t R0 = (size_t)b * SEQ;
    const int q = wid * 32 + r32, tok = q >> 2, head = q & 3;
    { LAS float* lut = (LAS float*)(lds + LUT_OFF);
      for (int e = tid; e < 4 * 129; e += 512) { const int r = e / 129, d = e % 129; const int bk = d >= 128 ? 31 : rel_bucket_dev(d);
          lut[r * LUT_PITCH + d] = p.in[I_RELB][bk * 8 + g * 4 + r] * LOG2E; }
      if (tid < 256) ((LAS unsigned*)(lds + SEL_OFF))[tid] = 0u; }
    const bf16_t* qrow = PROJ + (R0 + t0 + tok) * DINP;
    bf16x8 qr[4];
#pragma unroll
    for (int d0 = 0; d0 < 4; ++d0) qr[d0] = *(const bf16x8*)(qrow + 768 + (g * 4 + head) * 64 + d0 * 16 + hi * 8);
    float gate[3];
#pragma unroll
    for (int br = 0; br < 3; ++br) gate[br] = 1.f / (1.f + __expf(-bf2f(qrow[2048 + (g * 4 + head) * 3 + br])));
    __syncthreads();
    f32x16 o[2];
    const int nct = (4 * qt + 3 + 63) / 64;
    float mc = NEGV, lc = 0.f;
    o[0] = f32x16{}; o[1] = f32x16{};
    run_branch<0>(lds, KC, VC, 256, 0, 1, nct, qr, o, mc, lc, 0.f, t0, qt, tok, head, lane, wid);
    lc += __shfl_xor(lc, 32);
    const float linvc = (mc > -1e29f && lc > 0.f) ? 1.f / lc : 0.f;
    { float md = 0.f, ld = 0.f; float mcc = mc;
      run_branch<1>(lds, KC, VC, 256, 0, 1, nct, qr, o, mcc, ld, linvc, t0, qt, tok, head, lane, wid); (void)md; }
    accum_branch(lds, o, gate[0], true, lane, wid);
    __syncthreads();
    { LAS float* G = (LAS float*)(lds + IMP_OFF); LAS unsigned* selw = (LAS unsigned*)(lds + SEL_OFF);
      const int i = tid >> 3, sub = tid & 7; const int cur = qt;
      if (cur < 16) { if (sub < 4) { unsigned ones = 0xffffffffu; asm volatile("" : "+v"(ones)); selw[i * 4 + sub] = ones; } }
      else {
          for (int mm = 0; mm < 16; ++mm) { const int j = sub + 8 * mm; if (j <= cur) { float sc;
              if (j == 0 || j == cur || j == cur - 1) G[i * IMP_PITCH + j] = 1e30f; } }
          __syncthreads();
          for (int mm = 0; mm < 16; ++mm) { const int j = sub + 8 * mm; if (j <= cur) { const float sj = G[i * IMP_PITCH + j]; int cnt = 0;
              for (int jj = 0; jj <= cur; ++jj) { const float s2 = G[i * IMP_PITCH + jj]; cnt += (s2 > sj || (s2 == sj && jj < j)) ? 1 : 0; }
              if (cnt < 16) atomicOr((unsigned*)&selw[i * 4 + (j >> 5)], 1u << (j & 31)); } }
      } }
    __syncthreads();
    { float ms = NEGV, ls = 0.f; o[0] = f32x16{}; o[1] = f32x16{};
      run_pipe<2>(lds, PROJ + R0 * DINP + 1536 + g * 64, PROJ + R0 * DINP + 1664 + g * 64, qt + 1, qr, o, ls, qt, tok, head, lane, wid); (void)ms;
      ls += __shfl_xor(ls, 32);
      accum_branch(lds, o, gate[1] / ls, false, lane, wid); }
    { float mw = NEGV, lw = 0.f; o[0] = f32x16{}; o[1] = f32x16{};
      const int nw = qt + 1 < 9 ? qt + 1 : 9;
      run_pipe<3>(lds, PROJ + R0 * DINP + 1792 + g * 64, PROJ + R0 * DINP + 1920 + g * 64, nw, qr, o, lw, qt, tok, head, lane, wid); (void)mw;
      lw += __shfl_xor(lw, 32);
      accum_branch(lds, o, gate[2] / lw, false, lane, wid); }
    { LAS const float* st = (LAS const float*)(lds + OST_OFF) + wid * 2048 + lane;
#pragma unroll
    for (int r = 0; r < 16; ++r) { const int qq = wid * 32 + crow(r, hi); const int tk = qq >> 2, hd = qq & 3;
        bf16_t* dst = CAT + (R0 + t0 + tk) * DM + 512 + (g * 4 + hd) * 64 + r32;
        dst[0] = (bf16_t)f2bf(st[(r * 2) * 64]); dst[32] = (bf16_t)f2bf(st[(r * 2 + 1) * 64]); } }
    __syncthreads();
}

__device__ __forceinline__ void nsa_phase(const Params& p, int l, LAS unsigned char* lds, int vcu, int G) {
    for (int v = vcu; v < 256; v += G) {
        const int bg = v >> 4, s = v & 15;
        for (int i = 0; i < 8; ++i) { const int qt = (i >> 1) * 32 + ((i & 1) ? 31 - s : s); nsa_unit(p, l, lds, bg >> 1, bg & 1, qt); }
    }
}
}


#define XB_TMO      128
#define XB_XCNT(j)  (256  + 64 * (j))
#define XB_XSUB(j)  (1280 + 64 * (j))
#define XB_XGEN(j)  (2304 + 64 * (j))
#define XB_TOP      3328
#define XB_TOPGEN   3392
#define XCD_BAR_WORDS 3456
#define XB_SPIN_CAP (1u << 22)
__device__ __forceinline__ unsigned xb_ld(unsigned* p)              { return __hip_atomic_load(p, __ATOMIC_RELAXED, __HIP_MEMORY_SCOPE_AGENT); }
__device__ __forceinline__ unsigned xb_add(unsigned* p, unsigned v) { return __hip_atomic_fetch_add(p, v, __ATOMIC_RELAXED, __HIP_MEMORY_SCOPE_AGENT); }
__device__ __forceinline__ unsigned xb_xcc_id() { return (unsigned)__builtin_amdgcn_s_getreg((3 << 11) | 20) & 0xFu; }
#define XB_SPIN(cond, bar) do { unsigned _sp = 0; while (cond) { __builtin_amdgcn_s_sleep(1); \
    if ((++_sp & 255u) == 0u) { if (xb_ld(&(bar)[XB_TMO])) break; if (_sp > XB_SPIN_CAP) { atomicAdd(&(bar)[XB_TMO], 1u); break; } } } } while (0)
struct XcdBarrier { unsigned* bar; unsigned x; volatile LAS unsigned* st; };
__device__ __forceinline__ XcdBarrier xcd_barrier_post(unsigned* bar, volatile LAS unsigned* st) {
    XcdBarrier b; b.bar = bar; b.x = xb_xcc_id(); b.st = st;
    if (threadIdx.x == 0) (void)xb_add(&bar[XB_XCNT(b.x)], 1u);
    return b;
}
__device__ __forceinline__ void xcd_barrier_complete(unsigned* bar, unsigned x, unsigned& nloc, unsigned& nx) {
    const unsigned G = gridDim.x * gridDim.y * gridDim.z;
    unsigned sum, cnt, mine, sp = 0u;
    for (;;) {
        sum = 0u; cnt = 0u; mine = 0u;
#pragma unroll
        for (unsigned j = 0; j < 16; ++j) { const unsigned c = xb_ld(&bar[XB_XCNT(j)]); sum += c; cnt += (c > 0u) ? 1u : 0u; mine = (j == x) ? c : mine; }
        if (sum == G) break;
        __builtin_amdgcn_s_sleep(1);
        if ((++sp & 255u) == 0u) { if (xb_ld(&bar[XB_TMO])) break; if (sp > XB_SPIN_CAP) { atomicAdd(&bar[XB_TMO], 1u); break; } }
    }
    nloc = mine > 0u ? mine : 1u; nx = cnt > 0u ? cnt : 1u;
}
__device__ __forceinline__ void xcd_barrier(const XcdBarrier& b) {
    asm volatile("s_waitcnt vmcnt(0)" ::: "memory");
    __syncthreads();
    if (threadIdx.x == 0) {
        unsigned* bar = b.bar;
        __builtin_amdgcn_s_waitcnt(0);
        unsigned nloc = b.st[0], nx = b.st[1];
        if (nloc == 0u) { xcd_barrier_complete(bar, b.x, nloc, nx); b.st[0] = nloc; b.st[1] = nx; }
        const unsigned old = xb_add(&bar[XB_XSUB(b.x)], 1u);
        const unsigned gen = old / nloc;
        if (old + 1u == (gen + 1u) * nloc) {
            __builtin_amdgcn_fence(__ATOMIC_RELEASE, "agent");
            asm volatile("s_waitcnt vmcnt(0)" ::: "memory");
            const unsigned og = xb_add(&bar[XB_TOP], 1u);
            const unsigned tg = og / nx;
            if (og + 1u == (tg + 1u) * nx) xb_add(&bar[XB_TOPGEN], 1u);
            else XB_SPIN(xb_ld(&bar[XB_TOPGEN]) == tg, bar);
            __builtin_amdgcn_fence(__ATOMIC_ACQUIRE, "agent");
            xb_add(&bar[XB_XGEN(b.x)], 1u);
            asm volatile("s_waitcnt vmcnt(0)" ::: "memory");
        } else {
            XB_SPIN(xb_ld(&bar[XB_XGEN(b.x)]) == gen, bar);
            __builtin_amdgcn_fence(__ATOMIC_ACQUIRE, "agent");
            asm volatile("s_waitcnt vmcnt(0)" ::: "memory");
        }
    }
    __syncthreads();
}

__global__ void __launch_bounds__(512) hybrid_fwd(Params p) {
    extern __shared__ __attribute__((aligned(16))) unsigned char lds_raw[];
    LAS unsigned char* lds = (LAS unsigned char*)lds_raw;
    cg::grid_group grid = cg::this_grid();
    const int G = gridDim.x, bx = blockIdx.x;
    const int vcu = (G % 8 == 0) ? (bx % 8) * (G / 8) + bx / 8 : bx;
    unsigned char* ws = p.ws;
    volatile LAS unsigned* misc = (volatile LAS unsigned*)(lds + MISC_OFF);
    if (threadIdx.x < 2) misc[threadIdx.x] = 0u;
    __syncthreads();
    const XcdBarrier xbar = xcd_barrier_post((unsigned*)ws, misc);
    for (int ph = p.ph_lo; ph < p.ph_hi; ++ph) {
        if (ph == 0) prologue_phase(p, lds, vcu, G);
        else {
            const int l = (ph - 1) / 15, k = (ph - 1) % 15 + 1;
            unsigned char* wl = ws + WS_W + (size_t)l * WS_WL;
            int njobs = 0;
            if (k == 1) njobs = (l == 0) ? 5 : 1; else if (k == 3) njobs = 4; else if (k == 4) njobs = 2;
            else if (k == 6 || k == 8 || k == 9 || k == 10 || k == 11 || k == 13 || k == 14) njobs = 1;
#ifndef PROBE_MASK
#define PROBE_MASK 0
#endif
            const int nrep = ((PROBE_MASK >> k) & 1) ? 2 : 1;
            for (int rep = 0; rep < nrep; ++rep) {
            for (int job = 0; job < njobs; ++job) {
                pg8::Gemm g; pg8::Epi E; int M = MTOK, N = DM, c0 = 0;
                g.a_pn = 0; g.b_batch = 0; g.mtpb = 1 << 30; g.lda = DM; g.ldb = DM; g.K = DM;
                E.bias = nullptr; E.act = 0; E.sc_lo = 0; E.sc_hi = 0; E.sc = 1.f; E.ldc = DM;
                if (k == 1 && job == 0) { g.A = (const bf16_t*)(ws + WS_XN); g.Bt = (const bf16_t*)(wl + W_IN); N = DINP; E.O = (bf16_t*)(ws + WS_PROJ); E.ldc = DINP; E.sc_lo = 3; E.sc_hi = 5; E.sc = 0.125f * LOG2E; }
                else if (k == 1) { const int ll = (job - 1) >> 1; unsigned char* w2 = ws + WS_W + (size_t)ll * WS_WL;
                    if ((job - 1) & 1) { g.A = (const bf16_t*)(w2 + W_V); g.Bt = (const bf16_t*)(w2 + W_MEMN); M = DM; N = NB * NMEM; E.O = (bf16_t*)(ws + WS_VMT + (size_t)ll * 4 * MiB); E.ldc = NB * NMEM; }
                    else { g.A = (const bf16_t*)(w2 + W_MEMN); g.Bt = (const bf16_t*)(w2 + W_K); M = NB * NMEM; N = DM; E.O = (bf16_t*)(ws + WS_KM + (size_t)ll * 4 * MiB); }
                    c0 = 32 * (job - 1); }
                else if (k == 3 && job < 2) { g.A = (const bf16_t*)(ws + (job ? WS_VCRAW : WS_KCRAW)); g.lda = 1024; g.K = 2048; g.Bt = (const bf16_t*)(wl + (job ? W_CV1 : W_CK1)); g.ldb = 2048;
                    M = 8192; N = 256; E.O = (bf16_t*)(ws + (job ? WS_HIDV : WS_HIDK)); E.ldc = 256; E.act = 2; E.bias = (const float*)(wl + (job ? W_CB1V : W_CB1K)); c0 = job * 32; }
                else if (k == 3) { g.A = (const bf16_t*)(ws + WS_ACT) + (job == 3 ? 256 : 0); g.lda = 512; g.K = 256; g.Bt = (const bf16_t*)(wl + (job == 3 ? W_CPW : W_POOL)); g.ldb = 256;
                    N = 256; E.O = (bf16_t*)(ws + WS_CAT) + (job == 3 ? 256 : 0); c0 = 64; }
                else if (k == 4) { g.A = (const bf16_t*)(ws + (job ? WS_HIDV : WS_HIDK)); g.lda = 256; g.K = 256; g.Bt = (const bf16_t*)(wl + (job ? W_CV2 : W_CK2)); g.ldb = 256;
                    M = 8192; N = 256; E.O = (bf16_t*)(ws + (job ? WS_VC : WS_KC)); E.ldc = 256; c0 = job * 32; }
                else if (k == 6) { g.A = (const bf16_t*)(ws + WS_CAT); g.Bt = (const bf16_t*)(wl + W_OUT); E.O = (bf16_t*)(ws + WS_MIX); }
                else if (k == 8) { g.A = (const bf16_t*)(ws + WS_XN); g.Bt = (const bf16_t*)(wl + W_Q); E.O = (bf16_t*)(ws + WS_CAT); E.sc_lo = 0; E.sc_hi = 4; E.sc = 0.0625f * LOG2E; }
                else if (k == 9) { g.A = (const bf16_t*)(ws + WS_CAT); g.a_pn = 256; g.K = 256; g.Bt = (const bf16_t*)(ws + WS_KM + (size_t)l * 4 * MiB); g.b_pn = 256; g.b_batch = (size_t)NMEM * DM; g.mtpb = 32;
                    E.O = (bf16_t*)(ws + WS_PROJ); E.act = 3; }
                else if (k == 10) { g.A = (const bf16_t*)(ws + WS_PROJ); g.a_pn = 256; g.K = 256; g.Bt = (const bf16_t*)(ws + WS_VMT + (size_t)l * 4 * MiB); g.ldb = NB * NMEM; g.b_pn = (size_t)256 * NB * NMEM; g.b_batch = 256; g.mtpb = 32;
                    E.O = (bf16_t*)(ws + WS_CAT); }
                else if (k == 11) { g.A = (const bf16_t*)(ws + WS_CAT); g.Bt = (const bf16_t*)(wl + W_O); E.O = (bf16_t*)(ws + WS_MIX); }
                else if (k == 13) { g.A = (const bf16_t*)(ws + WS_XN); g.Bt = (const bf16_t*)(wl + W_1); N = FF; E.O = (bf16_t*)(ws + WS_HID); E.ldc = FF; E.act = 1; }
                else { g.A = (const bf16_t*)(ws + WS_HID); g.lda = FF; g.K = FF; g.Bt = (const bf16_t*)(wl + W_2); g.ldb = FF; E.O = (bf16_t*)(ws + WS_MIX); }
                if (!(k == 9 || k == 10)) g.b_pn = (size_t)256 * g.ldb;
                pg8::StaticOrder S; S.init(M, N, G, (bx - c0 + 4 * G) % G);
                pg8::gemm_phase(lds, g, S, E);
            }
            if (k == 2) prep_phase(p, l, lds, vcu, G);
            else if (k == 5) nsa::nsa_phase(p, l, lds, vcu, G);
            }
            if (0) {}
            else if (k == 7) rowwise_phase(l == 0 ? p.in[I_X] : p.out, p.out, (const bf16_t*)(ws + WS_MIX), p.in[I_MIXPOST] + l * DM, p.in[I_XAPRE] + l * DM, (bf16_t*)(ws + WS_XN), vcu, G);
            else if (k == 12) rowwise_phase(p.out, p.out, (const bf16_t*)(ws + WS_MIX), p.in[I_XAPOST] + l * DM, p.in[I_MLPPRE] + l * DM, (bf16_t*)(ws + WS_XN), vcu, G);
            else if (k == 15) rowwise_phase(p.out, p.out, (const bf16_t*)(ws + WS_MIX), p.in[I_MLPPOST] + l * DM, l == 0 ? p.in[I_MIXPRE] + DM : nullptr, (bf16_t*)(ws + WS_XN), vcu, G);
        }
        if (ph + 1 < p.ph_hi) { if (ph == 0) grid.sync(); else xcd_barrier(xbar); }
    }
}

extern "C" void kernel_launch(void* const* d_in, const int* in_sizes, int n_in, void* d_out, int out_size, void* d_ws, size_t ws_size, hipStream_t stream) {
    static int grid = 0;
    if (grid == 0) {
        if (n_in != 31 || ws_size < WS_END) { fprintf(stderr, "kernel_launch: unexpected inputs (n_in %d, ws %zu)\n", n_in, ws_size); grid = -1; return; }
        int dev = 0, cus = 0, per_cu = 0;
        hipGetDevice(&dev); hipDeviceGetAttribute(&cus, hipDeviceAttributeMultiprocessorCount, dev);
        hipFuncSetAttribute((const void*)hybrid_fwd, hipFuncAttributeMaxDynamicSharedMemorySize, LDS_BYTES);
        hipOccupancyMaxActiveBlocksPerMultiprocessor(&per_cu, (const void*)hybrid_fwd, 512, LDS_BYTES);
        (void)hipGetLastError();
        if (per_cu < 1) fprintf(stderr, "kernel_launch: occupancy query says %d blocks per CU\n", per_cu);
        grid = cus;
    }
    if (grid < 0) return;
    Params p{};
    for (int i = 0; i < 31; ++i) p.in[i] = (const float*)d_in[i];
    p.out = (float*)d_out; p.ws = (unsigned char*)d_ws; p.ph_lo = 0; p.ph_hi = 31;
    void* args[] = {&p};
    (void)hipMemsetAsync(d_ws, 0, 16384, stream);
    hipError_t e = hipLaunchCooperativeKernel((const void*)hybrid_fwd, dim3(grid), dim3(512), args, LDS_BYTES, stream);
    if (e != hipSuccess) fprintf(stderr, "cooperative launch failed: %s (grid %d)\n", hipGetErrorString(e), grid);
}
```

```cpp
#include <hip/hip_runtime.h>
#include <hip/hip_cooperative_groups.h>
#include <cstdio>
#include <cstdint>
#include <cmath>
namespace cg = cooperative_groups;

#define LAS __attribute__((address_space(3)))
typedef unsigned short bf16_t;
typedef short bf16x8 __attribute__((ext_vector_type(8)));
typedef short s16x4 __attribute__((ext_vector_type(4)));
typedef float f32x4 __attribute__((ext_vector_type(4)));
typedef float f32x2 __attribute__((ext_vector_type(2)));
typedef float f32x16 __attribute__((ext_vector_type(16)));
typedef unsigned u32x4 __attribute__((ext_vector_type(4)));
typedef unsigned u32x2 __attribute__((ext_vector_type(2)));

constexpr int NB = 8, SEQ = 8192, DM = 1024, MTOK = NB * SEQ, DINP = 2304, FF = 4096, NMEM = 256;
constexpr float LOG2E = 1.4426950408889634f;
constexpr float EPS = 1e-6f;
constexpr float NEGV = -1e30f;

constexpr size_t MiB = 1u << 20;
constexpr size_t WS_W = 1 * MiB, WS_WL = 40 * MiB;
constexpr size_t W_IN = 0, W_OUT = 5 * MiB, W_Q = 7 * MiB, W_O = 9 * MiB, W_1 = 11 * MiB, W_2 = 19 * MiB, W_K = 27 * MiB, W_V = 29 * MiB,
                 W_CK1 = 31 * MiB, W_CV1 = 32 * MiB, W_CK2 = 33 * MiB, W_CV2 = 33 * MiB + 128 * 1024, W_POOL = 33 * MiB + 256 * 1024,
                 W_CPW = 33 * MiB + 384 * 1024, W_CB1K = 33 * MiB + 512 * 1024, W_CB1V = 33 * MiB + 516 * 1024, W_MEMN = 34 * MiB;
constexpr size_t WS_KM = 82 * MiB, WS_VMT = 90 * MiB;
constexpr size_t WS_KCRAW = 100 * MiB, WS_VCRAW = 117 * MiB;
constexpr size_t WS_HIDK = 134 * MiB, WS_HIDV = 138 * MiB, WS_KC = 142 * MiB, WS_VC = 146 * MiB;
constexpr size_t WS_XN = 160 * MiB, WS_MIX = 288 * MiB, WS_BIG = 416 * MiB;
constexpr size_t WS_PROJ = WS_BIG, WS_CAT = 704 * MiB, WS_ACT = 832 * MiB, WS_HID = WS_BIG;
constexpr size_t WS_WQK = 288 * MiB  , WS_VWO = 320 * MiB  ;
constexpr size_t WS_XRES = 160 * MiB  , WS_RSTD = 154 * MiB  ;
constexpr size_t WS_XB1 = 150 * MiB, WS_XB2 = 152 * MiB;
constexpr size_t CTL_CNT1 = 65536, CTL_CNT2 = 131072, CTL_ZERO = 262144;
constexpr size_t WS_END = 928 * MiB;

constexpr int LDS_BYTES = 163840;
constexpr int MISC_OFF = 152576;
constexpr int XS_OFF = 131072;

__device__ __forceinline__ unsigned f2bf(float f) { unsigned u = __builtin_bit_cast(unsigned, f); return (u + 0x7fffu + ((u >> 16) & 1u)) >> 16; }
__device__ __forceinline__ unsigned pk2(float lo, float hi) { return f2bf(lo) | (f2bf(hi) << 16); }
__device__ __forceinline__ float bf2f(unsigned short b) { return __builtin_bit_cast(float, (unsigned)b << 16); }
__device__ __forceinline__ unsigned cvt_pk_bf16(float lo, float hi) { unsigned r; asm volatile("v_cvt_pk_bf16_f32 %0, %1, %2" : "=v"(r) : "v"(lo), "v"(hi)); return r; }
template <int K> __device__ __forceinline__ float shx(float v) { return __builtin_bit_cast(float, __builtin_amdgcn_ds_swizzle(__builtin_bit_cast(int, v), (K << 10) | 0x1f)); }
template <int K> __device__ __forceinline__ int shxi(int v) { return __builtin_amdgcn_ds_swizzle(v, (K << 10) | 0x1f); }
__device__ __forceinline__ float sum32(float v) { const unsigned u = __builtin_bit_cast(unsigned, v); auto rr = __builtin_amdgcn_permlane32_swap(u, u, false, false); return __builtin_bit_cast(float, (unsigned)rr[0]) + __builtin_bit_cast(float, (unsigned)rr[1]); }
__device__ __forceinline__ float max32(float v) { const unsigned u = __builtin_bit_cast(unsigned, v); auto rr = __builtin_amdgcn_permlane32_swap(u, u, false, false); return fmaxf(__builtin_bit_cast(float, (unsigned)rr[0]), __builtin_bit_cast(float, (unsigned)rr[1])); }
__device__ __forceinline__ float xch32(float v, int hi) { const unsigned u = __builtin_bit_cast(unsigned, v); auto rr = __builtin_amdgcn_permlane32_swap(u, u, false, false); return __builtin_bit_cast(float, (unsigned)(hi ? rr[0] : rr[1])); }
__device__ __forceinline__ float wave_sum(float v) {
    v += shx<1>(v); v += shx<2>(v); v += shx<4>(v); v += shx<8>(v); v += shx<16>(v);
    return sum32(v);
}
__device__ __forceinline__ float ex2(float x) { return __builtin_amdgcn_exp2f(x); }
constexpr int TKT_OFF = 152576 + 16;
__device__ __forceinline__ int opaque_tid() {
    extern __shared__ __attribute__((aligned(16))) unsigned char lds_tk_[];
    const unsigned hw = (unsigned)__builtin_amdgcn_s_getreg((5 << 11) | 4) & 63u;
    const unsigned w = ((volatile LAS unsigned*)((LAS unsigned char*)lds_tk_ + TKT_OFF))[hw];
    int lane; asm volatile("v_mbcnt_lo_u32_b32 %0, -1, 0\n\tv_mbcnt_hi_u32_b32 %0, -1, %0" : "=v"(lane));
    return (int)(__builtin_amdgcn_readfirstlane(w) * 64u) + lane;
}

namespace pg8 {
constexpr int BM = 256, BK = 64, HALF = 128, HTB = HALF * BK * 2, STAGE_BYTES = 8 * HTB, NXCD = 8, WGM = 8;
__host__ __device__ __forceinline__ int lds_byte(int r, int c) { const int st = (r >> 4) * 2 + (c >> 5), rr = r & 15, cc = c & 31, ob = rr * 64 + cc * 2; return st * 1024 + (ob ^ (((ob >> 9) & 1) << 5)); }
__host__ __device__ __forceinline__ void stage_rc(int b, int& R, int& C) { const int st = b / 1024, sb = b % 1024, swz = sb ^ (((sb >> 9) & 1) << 5); R = (st >> 1) * 16 + swz / 64; C = (st & 1) * 32 + (swz % 64) / 2; }
__host__ __device__ __forceinline__ int perm32(int rho) { const int n = rho >> 4, i = rho & 15; return 8 * (i >> 2) + 4 * n + (i & 3); }

struct Unit { int pm, pn; };
struct Gemm {
    const bf16_t* A; const bf16_t* Bt; int lda, ldb, K; size_t a_pn, b_pn, b_batch; int mtpb;
    __device__ __forceinline__ const char* a_ptr(const Unit& u) const { return (const char*)(A + (size_t)u.pm * BM * lda + (size_t)u.pn * a_pn); }
    __device__ __forceinline__ const char* b_ptr(const Unit& u) const { return (const char*)(Bt + (size_t)u.pn * b_pn + (size_t)(u.pm / mtpb) * b_batch); }
};
struct StaticOrder {
    int nM, nN, nwg, G, c;
    __device__ void init(int M, int N, int G_, int c_) { nM = M / BM; nN = N / BM; nwg = nM * nN; G = G_; c = c_; }
    __device__ bool next(int i, Unit& u) const {
        const long L = (long)i * G + c; if (L >= nwg) return false;
        int wgid = (int)L; { const int q = nwg / NXCD, r = nwg % NXCD, xcd = wgid % NXCD, off = wgid / NXCD; wgid = (xcd < r ? xcd * (q + 1) : r * (q + 1) + (xcd - r) * q) + off; }
        const int nig = WGM * nN, gid = wgid / nig, fm = gid * WGM, gsz = (nM - fm) < WGM ? (nM - fm) : WGM;
        u.pm = fm + ((wgid % nig) % gsz); u.pn = (wgid % nig) / gsz; return true;
    }
};

__device__ __forceinline__ void panel_ss(const f32x4 (&v)[2][2][4][2], const Unit& u, int wr, int wc, int fr, int fq, LAS unsigned char* xs,
                                         float* xbuf, unsigned* cnt, unsigned want, float (&rstd)[2][4], float* rstd_out) {
    const int tid = opaque_tid(), wid = tid >> 6, lane = tid & 63;
    LAS float* P = (LAS float*)xs;
    LAS float* S = (LAS float*)(xs + 4096);
#pragma unroll
    for (int ai = 0; ai < 2; ++ai)
#pragma unroll
        for (int m = 0; m < 4; ++m) {
            float q = 0.f;
#pragma unroll
            for (int bj = 0; bj < 2; ++bj)
#pragma unroll
                for (int n = 0; n < 2; ++n) { const f32x4 x = v[ai][bj][m][n]; q += (x[0] * x[0] + x[1] * x[1]) + (x[2] * x[2] + x[3] * x[3]); }
            q += shx<16>(q); q = sum32(q);
            if (fq == 0) P[(ai * HALF + wr * 64 + m * 16 + fr) * 4 + wc] = q;
        }
    asm volatile("s_waitcnt lgkmcnt(0)" ::: "memory"); __builtin_amdgcn_s_barrier(); asm volatile("" ::: "memory");
    const int row = wid * 32 + (lane & 31);
    if (lane < 32) {
        const float tot = (P[row * 4 + 0] + P[row * 4 + 1]) + (P[row * 4 + 2] + P[row * 4 + 3]);
        __hip_atomic_store(xbuf + ((size_t)(u.pm * BM + row) * 4 + u.pn), tot, __ATOMIC_RELAXED, __HIP_MEMORY_SCOPE_AGENT);
    }
    if (want == 0u) return;
    asm volatile("s_waitcnt vmcnt(0)" ::: "memory");
    if (lane == 0) __hip_atomic_fetch_add(cnt + 64 * u.pm, 1u, __ATOMIC_RELAXED, __HIP_MEMORY_SCOPE_AGENT);
    if (wid == 0) {
        for (unsigned spin = 0; spin < (1u << 22); ++spin) {
            if ((unsigned)__builtin_amdgcn_readfirstlane(__hip_atomic_load(cnt + 64 * u.pm, __ATOMIC_RELAXED, __HIP_MEMORY_SCOPE_AGENT)) >= want) break;
            __builtin_amdgcn_s_sleep(0);
        }
        __builtin_amdgcn_fence(__ATOMIC_ACQUIRE, "agent");
    }
    asm volatile("s_waitcnt vmcnt(0) lgkmcnt(0)" ::: "memory"); __builtin_amdgcn_s_barrier(); asm volatile("" ::: "memory");
    if (lane < 32) {
        const float* slot = xbuf + (size_t)(u.pm * BM + row) * 4; float t = 0.f;
#pragma unroll
        for (int k = 0; k < 4; ++k) t += __hip_atomic_load(slot + k, __ATOMIC_RELAXED, __HIP_MEMORY_SCOPE_AGENT);
        const float rsv = 1.0f / sqrtf(t * (1.f / 1024.f) + EPS); S[row] = rsv;
        if (rstd_out && u.pn == 0) rstd_out[u.pm * BM + row] = rsv;
    }
    asm volatile("s_waitcnt vmcnt(0) lgkmcnt(0)" ::: "memory"); __builtin_amdgcn_s_barrier(); asm volatile("" ::: "memory");
#pragma unroll
    for (int ai = 0; ai < 2; ++ai)
#pragma unroll
        for (int m = 0; m < 4; ++m) rstd[ai][m] = S[ai * HALF + wr * 64 + m * 16 + fr];
    asm volatile("s_waitcnt lgkmcnt(0)" ::: "memory");
}

struct Epi {
    bf16_t* O; int ldc; unsigned o_pm, o_pn; const float* bias; int act; int sc_lo, sc_hi; float sc;
    const bf16_t* xres; bf16_t* xres_out; float* xout_f32; const float* gpost; float* rstd_out; const float* rscale; float* xb1; float* xb2; unsigned* cnt1; unsigned* cnt2; unsigned want;
    template <int MODE>
    __device__ __forceinline__ void run(f32x4 (&acc)[2][2][4][2], const Unit& u, int wr, int wc, int fr_in, int fq_in, LAS unsigned char* xs) const {
        int fr = fr_in, fq = fq_in; asm volatile("" : "+v"(fr), "+v"(fq));
        const int row0_ = u.pm * BM + wr * 64 + fr; const int col0_ = u.pn * BM + wc * 32 + 8 * fq;
        const float s = (u.pn >= sc_lo && u.pn < sc_hi) ? sc : 1.f;
        if (MODE == 1) {
            int row0 = row0_, col0 = col0_; asm volatile("" : "+v"(row0), "+v"(col0));
            float rs[2][4];
            u32x4 xh[2][2];
#pragma unroll
            for (int gi = 0; gi < 2; ++gi) { const size_t off = (size_t)(row0 + gi * 16) * 1024 + col0;
#pragma unroll
                for (int bj = 0; bj < 2; ++bj) xh[gi][bj] = *(const u32x4*)(xres + off + bj * HALF); }
            panel_ss(acc, u, wr, wc, fr, fq, xs, xb1, cnt1, want, rs, nullptr);
            f32x4 gp[2][2];
#pragma unroll
            for (int bj = 0; bj < 2; ++bj)
#pragma unroll
                for (int n = 0; n < 2; ++n) gp[bj][n] = *(const f32x4*)(gpost + col0 + bj * HALF + 4 * n);
#pragma unroll
            for (int gi = 0; gi < 8; ++gi) { const int ai = gi >> 2, m = gi & 3;
                const size_t off = (size_t)(row0 + ai * HALF + m * 16) * 1024 + col0; const float r1 = rs[ai][m];
                u32x4 hcur[2]; hcur[0] = xh[gi & 1][0]; hcur[1] = xh[gi & 1][1];
                if (gi + 2 < 8) { const int a2 = (gi + 2) >> 2, m2 = (gi + 2) & 3; const size_t off2 = (size_t)(row0 + a2 * HALF + m2 * 16) * 1024 + col0;
#pragma unroll
                    for (int bj = 0; bj < 2; ++bj) xh[gi & 1][bj] = *(const u32x4*)(xres + off2 + bj * HALF); }
#pragma unroll
                for (int bj = 0; bj < 2; ++bj) { const u32x4 h = hcur[bj];
                    f32x4 xv0, xv1;
                    xv0[0] = __builtin_bit_cast(float, h.x << 16); xv0[1] = __builtin_bit_cast(float, h.x & 0xffff0000u); xv0[2] = __builtin_bit_cast(float, h.y << 16); xv0[3] = __builtin_bit_cast(float, h.y & 0xffff0000u);
                    xv1[0] = __builtin_bit_cast(float, h.z << 16); xv1[1] = __builtin_bit_cast(float, h.z & 0xffff0000u); xv1[2] = __builtin_bit_cast(float, h.w << 16); xv1[3] = __builtin_bit_cast(float, h.w & 0xffff0000u);
                    const f32x4 a0 = xv0 + acc[ai][bj][m][0] * r1 * gp[bj][0], a1 = xv1 + acc[ai][bj][m][1] * r1 * gp[bj][1];
                    if (xout_f32) { *(f32x4*)(xout_f32 + off + bj * HALF) = a0; *(f32x4*)(xout_f32 + off + bj * HALF + 4) = a1; acc[ai][bj][m][0] = a0; acc[ai][bj][m][1] = a1; }
                    else { u32x4 w; w.x = cvt_pk_bf16(a0[0], a0[1]); w.y = cvt_pk_bf16(a0[2], a0[3]); w.z = cvt_pk_bf16(a1[0], a1[1]); w.w = cvt_pk_bf16(a1[2], a1[3]);
                        *(u32x4*)(xres_out + off + bj * HALF) = w;
                        f32x4 b0, b1; b0[0] = __builtin_bit_cast(float, w.x << 16); b0[1] = __builtin_bit_cast(float, w.x & 0xffff0000u); b0[2] = __builtin_bit_cast(float, w.y << 16); b0[3] = __builtin_bit_cast(float, w.y & 0xffff0000u);
                        b1[0] = __builtin_bit_cast(float, w.z << 16); b1[1] = __builtin_bit_cast(float, w.z & 0xffff0000u); b1[2] = __builtin_bit_cast(float, w.w << 16); b1[3] = __builtin_bit_cast(float, w.w & 0xffff0000u);
                        acc[ai][bj][m][0] = b0; acc[ai][bj][m][1] = b1; } }
                asm volatile("" : "+v"(acc[ai][0][m][0]), "+v"(acc[ai][0][m][1]), "+v"(acc[ai][1][m][0]), "+v"(acc[ai][1][m][1]));
                asm volatile("" ::: "memory"); }
            if (rstd_out) panel_ss(acc, u, wr, wc, fr, fq, xs, xb2, cnt2, 0u, rs, nullptr);
            return;
        }
        const int row0 = row0_, col0 = col0_;
        if (MODE == 2) {
            int fr_o = fr; asm volatile("" : "+v"(fr_o));
            LAS f32x2* XS = (LAS f32x2*)xs;
            float mloc[2][4];
#pragma unroll
            for (int ai = 0; ai < 2; ++ai)
#pragma unroll
                for (int m = 0; m < 4; ++m) {
                    float mx = NEGV; float rsc = s; if (rscale) { const f32x4 pr = *(const f32x4*)(rscale + 4 * (size_t)(row0 + ai * HALF + m * 16)); rsc *= 1.0f / sqrtf(((pr[0] + pr[1]) + (pr[2] + pr[3])) * (1.f / 1024.f) + EPS); }
#pragma unroll
                    for (int bj = 0; bj < 2; ++bj)
#pragma unroll
                        for (int n = 0; n < 2; ++n) { const f32x4 x = acc[ai][bj][m][n] * rsc; acc[ai][bj][m][n] = x; mx = fmaxf(mx, fmaxf(fmaxf(x[0], x[1]), fmaxf(x[2], x[3]))); }
                    mx = fmaxf(mx, shx<16>(mx)); mx = max32(mx);
                    float sm = 0.f;
#pragma unroll
                    for (int bj = 0; bj < 2; ++bj)
#pragma unroll
                        for (int n = 0; n < 2; ++n) { f32x4 x = acc[ai][bj][m][n]; x[0] = ex2(x[0] - mx); x[1] = ex2(x[1] - mx); x[2] = ex2(x[2] - mx); x[3] = ex2(x[3] - mx); acc[ai][bj][m][n] = x; sm += (x[0] + x[1]) + (x[2] + x[3]); }
                    sm += shx<16>(sm); sm = sum32(sm);
                    mloc[ai][m] = mx;
                    if (fq == 0) XS[(ai * HALF + wr * 64 + m * 16 + fr_o) * 4 + wc] = (f32x2){mx, sm};
                }
            asm volatile("s_waitcnt lgkmcnt(0)" ::: "memory"); __builtin_amdgcn_s_barrier(); asm volatile("" ::: "memory");
#pragma unroll
            for (int ai = 0; ai < 2; ++ai)
#pragma unroll
                for (int m = 0; m < 4; ++m) {
                    const int r = ai * HALF + wr * 64 + m * 16 + fr_o;
                    const f32x2 a = XS[r * 4 + 0], b = XS[r * 4 + 1], c = XS[r * 4 + 2], d = XS[r * 4 + 3];
                    const float mt = fmaxf(fmaxf(a.x, b.x), fmaxf(c.x, d.x));
                    const float l = a.y * ex2(a.x - mt) + b.y * ex2(b.x - mt) + c.y * ex2(c.x - mt) + d.y * ex2(d.x - mt);
                    const float f = ex2(mloc[ai][m] - mt) / l;
                    bf16_t* rowp = O + (size_t)u.pm * o_pm + (size_t)u.pn * o_pn + (size_t)(wr * 64 + fr + ai * HALF + m * 16) * ldc + wc * 32 + 8 * fq;
#pragma unroll
                    for (int bj = 0; bj < 2; ++bj) { const f32x4 v0 = acc[ai][bj][m][0] * f, v1 = acc[ai][bj][m][1] * f;
                        u32x4 w; w.x = cvt_pk_bf16(v0[0], v0[1]); w.y = cvt_pk_bf16(v0[2], v0[3]); w.z = cvt_pk_bf16(v1[0], v1[1]); w.w = cvt_pk_bf16(v1[2], v1[3]);
                        *(u32x4*)(rowp + bj * HALF) = w; }
                }
            return;
        }
        f32x4 bv[2][2];
#pragma unroll
        for (int bj = 0; bj < 2; ++bj)
#pragma unroll
            for (int n = 0; n < 2; ++n) bv[bj][n] = bias ? *(const f32x4*)(bias + col0 + bj * HALF + 4 * n) : (f32x4){0.f, 0.f, 0.f, 0.f};
#pragma unroll
        for (int ai = 0; ai < 2; ++ai)
#pragma unroll
            for (int m = 0; m < 4; ++m) { bf16_t* rowp = O + (size_t)u.pm * o_pm + (size_t)u.pn * o_pn + (size_t)(wr * 64 + fr + ai * HALF + m * 16) * ldc + wc * 32 + 8 * fq;
                float rsc = 1.f; if (rscale) { const f32x4 pr = *(const f32x4*)(rscale + 4 * (size_t)(row0 + ai * HALF + m * 16)); rsc = 1.0f / sqrtf(((pr[0] + pr[1]) + (pr[2] + pr[3])) * (1.f / 1024.f) + EPS); }
#pragma unroll
                for (int bj = 0; bj < 2; ++bj) { f32x4 v0 = acc[ai][bj][m][0] * rsc + bv[bj][0], v1 = acc[ai][bj][m][1] * rsc + bv[bj][1];
                    if (act == 1) {
#pragma unroll
                        for (int e = 0; e < 4; ++e) { float a = fmaxf(v0[e], 0.f), b = fmaxf(v1[e], 0.f); v0[e] = a * a; v1[e] = b * b; }
                    } else if (act == 2) {
#pragma unroll
                        for (int e = 0; e < 4; ++e) { float a = v0[e], b = v1[e];
                            float ua = 1.5957691216f * (a + 0.044715f * a * a * a), ub = 1.5957691216f * (b + 0.044715f * b * b * b);
                            v0[e] = a / (1.f + __expf(-ua)); v1[e] = b / (1.f + __expf(-ub)); }
                    }
                    v0 = v0 * s; v1 = v1 * s; u32x4 w; w.x = cvt_pk_bf16(v0[0], v0[1]); w.y = cvt_pk_bf16(v0[2], v0[3]); w.z = cvt_pk_bf16(v1[0], v1[1]); w.w = cvt_pk_bf16(v1[2], v1[3]);
                    *(u32x4*)(rowp + bj * HALF) = w; } }
    }
};

template <int MODE>
__device__ __forceinline__ void gemm_phase(LAS unsigned char* lds, const Gemm g, const StaticOrder& S, const Epi& E) {
    const int tid = opaque_tid(), wid = __builtin_amdgcn_readfirstlane(tid >> 6), lane = tid & 63, wr = wid >> 2, wc = wid & 3, fr = lane & 15, fq = lane >> 4;
    const int K = g.K, nt = K / BK;
    unsigned voffA[2], voffB[2];
#pragma unroll
    for (int i = 0; i < 2; ++i) { int R, C; stage_rc(tid * 16 + i * 8192, R, C); const int Rb = (R & ~31) + perm32(R & 31);
        voffA[i] = (unsigned)(R * g.lda + C) * 2u; voffB[i] = (unsigned)(Rb * g.ldb + C) * 2u; }
    const size_t kstep = (size_t)(BK * 2);
    const size_t hA = (size_t)HALF * g.lda * 2, hB = (size_t)HALF * g.ldb * 2;
    const unsigned ldsw = (unsigned)wid * 1024u;
    const int aoff = lds_byte(wr * 64 + fr, fq * 8), boff = lds_byte(wc * 32 + fr, fq * 8);
#define PG8_SA(b, h) (((b) * 2 + (h)) * HTB)
#define PG8_SB(b, h) ((4 + (b) * 2 + (h)) * HTB)
#define PG8_STAGE(bufoff, gbase, voff) do { _Pragma("unroll") for (int _i = 0; _i < 2; ++_i) \
        __builtin_amdgcn_global_load_lds((const unsigned*)((const char*)(gbase) + (voff)[_i]), (LAS unsigned*)(lds + (bufoff) + ldsw + _i * 8192), 16, 0, 0); } while (0)
#define PG8_LDA(dst, b, h) do { _Pragma("unroll") for (int m = 0; m < 4; ++m) _Pragma("unroll") for (int k = 0; k < 2; ++k) dst[m][k] = *(const LAS bf16x8*)(lds + PG8_SA(b, h) + aoff + m * 2048 + k * 1024); } while (0)
#define PG8_LDB(dst, b, h) do { _Pragma("unroll") for (int n = 0; n < 2; ++n) _Pragma("unroll") for (int k = 0; k < 2; ++k) dst[n][k] = *(const LAS bf16x8*)(lds + PG8_SB(b, h) + boff + n * 2048 + k * 1024); } while (0)
#define PG8_MMA(ai, bj, At, Bt) do { __builtin_amdgcn_s_setprio(1); _Pragma("unroll") for (int m = 0; m < 4; ++m) _Pragma("unroll") for (int n = 0; n < 2; ++n) _Pragma("unroll") for (int k = 0; k < 2; ++k) \
        acc[ai][bj][m][n] = __builtin_amdgcn_mfma_f32_16x16x32_bf16(Bt[n][k], At[m][k], acc[ai][bj][m][n], 0, 0, 0); __builtin_amdgcn_s_setprio(0); } while (0)
#define PG8_WAIT_V(n) asm volatile("s_waitcnt vmcnt(" #n ")" ::: "memory")
#define PG8_WAIT_L(n) asm volatile("s_waitcnt lgkmcnt(" #n ")" ::: "memory")
#define PG8_BAR __builtin_amdgcn_s_barrier()
#define PG8_SCHED __builtin_amdgcn_sched_barrier(0)
    Unit cur, nxt; int ui = 0;
    if (!S.next(0, cur)) return;
    f32x4 acc[2][2][4][2];
#pragma unroll
    for (int a = 0; a < 2; ++a)
#pragma unroll
        for (int b = 0; b < 2; ++b)
#pragma unroll
            for (int m = 0; m < 4; ++m)
#pragma unroll
                for (int n = 0; n < 2; ++n) acc[a][b][m][n] = (f32x4){0.f, 0.f, 0.f, 0.f};
    bf16x8 At[4][2], B0[2][2], B1[2][2];
    const char* cA = g.a_ptr(cur); const char* cB = g.b_ptr(cur);
    PG8_STAGE(PG8_SB(0, 0), cB, voffB); PG8_STAGE(PG8_SB(0, 1), cB + hB, voffB); PG8_STAGE(PG8_SA(0, 0), cA, voffA); PG8_STAGE(PG8_SA(0, 1), cA + hA, voffA);
    if (wr == 1) PG8_BAR;
    PG8_WAIT_V(2); PG8_BAR;
    PG8_STAGE(PG8_SB(1, 0), cB + kstep, voffB); PG8_STAGE(PG8_SA(1, 0), cA + kstep, voffA); PG8_STAGE(PG8_SB(1, 1), cB + hB + kstep, voffB);
    PG8_WAIT_V(6); PG8_BAR;
    for (;;) {
        const bool has_next = S.next(ui + 1, nxt);
        const char* nA = has_next ? g.a_ptr(nxt) : cA; const char* nB = has_next ? g.b_ptr(nxt) : cB;
        for (int t = 0; t < nt; t += 2) {
            const bool last = (t == nt - 2);
            const char* a1 = cA + (size_t)(t + 1) * kstep;
            const char* a2 = last ? nA : cA + (size_t)(t + 2) * kstep; const char* b2 = last ? nB : cB + (size_t)(t + 2) * kstep;
            const char* a3 = a2 + kstep; const char* b3 = b2 + kstep;
            PG8_LDB(B0, 0, 0); PG8_LDB(B1, 0, 1); PG8_SCHED; PG8_LDA(At, 0, 0); PG8_STAGE(PG8_SA(1, 1), a1 + hA, voffA);
            PG8_WAIT_V(8); PG8_WAIT_L(0); PG8_BAR; PG8_MMA(0, 0, At, B0); PG8_MMA(0, 1, At, B1); PG8_BAR; PG8_SCHED;
            PG8_LDA(At, 0, 1); PG8_STAGE(PG8_SB(0, 0), b2, voffB); PG8_STAGE(PG8_SB(0, 1), b2 + hB, voffB); PG8_STAGE(PG8_SA(0, 0), a2, voffA);
            PG8_WAIT_V(8); PG8_WAIT_L(0); PG8_BAR; PG8_MMA(1, 0, At, B0); PG8_MMA(1, 1, At, B1); PG8_BAR; PG8_SCHED;
            PG8_LDB(B0, 1, 0); PG8_LDB(B1, 1, 1); PG8_SCHED; PG8_LDA(At, 1, 0); PG8_STAGE(PG8_SA(0, 1), a2 + hA, voffA);
            PG8_WAIT_V(8); PG8_WAIT_L(0); PG8_BAR; PG8_MMA(0, 0, At, B0); PG8_MMA(0, 1, At, B1); PG8_BAR; PG8_SCHED;
            PG8_LDA(At, 1, 1); PG8_STAGE(PG8_SB(1, 0), b3, voffB); PG8_STAGE(PG8_SB(1, 1), b3 + hB, voffB); PG8_STAGE(PG8_SA(1, 0), a3, voffA);
            PG8_WAIT_V(8); PG8_WAIT_L(0); PG8_BAR; PG8_MMA(1, 0, At, B0); PG8_MMA(1, 1, At, B1); PG8_BAR; PG8_SCHED;
        }
        if (wr == 0) PG8_BAR;
        E.template run<MODE>(acc, cur, wr, wc, fr, fq, lds + XS_OFF);
        if (!has_next) break;
#pragma unroll
        for (int a = 0; a < 2; ++a)
#pragma unroll
            for (int b = 0; b < 2; ++b)
#pragma unroll
                for (int m = 0; m < 4; ++m)
#pragma unroll
                    for (int n = 0; n < 2; ++n) acc[a][b][m][n] = (f32x4){0.f, 0.f, 0.f, 0.f};
        cur = nxt; cA = nA; cB = nB; ++ui;
        if (wr == 1) PG8_BAR;
    }
    PG8_WAIT_V(0);
    PG8_BAR;
#undef PG8_SA
#undef PG8_SB
#undef PG8_STAGE
#undef PG8_LDA
#undef PG8_LDB
#undef PG8_MMA
#undef PG8_WAIT_V
#undef PG8_WAIT_L
#undef PG8_BAR
#undef PG8_SCHED
}
}

struct Params {
    const float* in[31];
    float* out;
    unsigned char* ws;
    int ph_lo, ph_hi;
};
enum { I_X = 0, I_MEM, I_RELB, I_MIXPRE, I_MIXPOST, I_WIN, I_POOLW, I_POOLS, I_CONVW, I_CONVB, I_CLNG, I_CLNB, I_CPW, I_CKPOS, I_CKW1, I_CKW2,
       I_CVPOS, I_CVW1, I_CVW2, I_WOUT, I_XAPRE, I_XAPOST, I_MEMG, I_WQ, I_WK, I_WV, I_WO, I_MLPPRE, I_MLPPOST, I_W1, I_W2 };

__device__ __forceinline__ void tr_item(const float* W, int K, int N, int Npad, bf16_t* WT, LAS float* scr, int item, int lane, const float* gk = nullptr) {
    const int nblk = Npad / 32, kb = item / nblk, nb = item % nblk, k0 = 64 * kb, n0 = 32 * nb;
    const int krow = lane >> 3, nq = n0 + 4 * (lane & 7);
#pragma unroll
    for (int hb = 0; hb < 2; ++hb) {
        f32x4 wv4[4];
#pragma unroll
        for (int i = 0; i < 4; ++i) { const int kk = 8 * (4 * hb + i) + krow; wv4[i] = (nq < N) ? *(const f32x4*)(W + (size_t)(k0 + kk) * N + nq) : (f32x4){0.f, 0.f, 0.f, 0.f}; }
#pragma unroll
        for (int i = 0; i < 4; ++i) { const int kk = 8 * (4 * hb + i) + krow; f32x4 w = wv4[i]; if (gk) w = w * gk[k0 + kk];
            LAS float* d = scr + kk * 33 + 4 * (lane & 7); d[0] = w.x; d[1] = w.y; d[2] = w.z; d[3] = w.w; }
    }
    asm volatile("s_waitcnt lgkmcnt(0)" ::: "memory");
    const int c = lane & 7;
#pragma unroll
    for (int j = 0; j < 4; ++j) { const int n = (lane >> 3) + 8 * j; const LAS float* s = scr + (8 * c) * 33 + n;
        u32x4 o; o.x = pk2(s[0 * 33], s[1 * 33]); o.y = pk2(s[2 * 33], s[3 * 33]); o.z = pk2(s[4 * 33], s[5 * 33]); o.w = pk2(s[6 * 33], s[7 * 33]);
        *(u32x4*)(WT + (size_t)(n0 + n) * K + k0 + 8 * c) = o; }
    asm volatile("s_waitcnt lgkmcnt(0)" ::: "memory");
}
__device__ __forceinline__ void rms_row_to_bf16(const float* xrow, const float* g, bf16_t* orow, int lane) {
    const f32x4* xr = (const f32x4*)xrow + lane; const f32x4* gr = (const f32x4*)g + lane;
    f32x4 v[4]; float s = 0.f;
#pragma unroll
    for (int j = 0; j < 4; ++j) { v[j] = xr[64 * j]; s += (v[j].x * v[j].x + v[j].y * v[j].y) + (v[j].z * v[j].z + v[j].w * v[j].w); }
    const float rstd = 1.f / sqrtf(wave_sum(s) * (1.f / DM) + EPS);
    u32x2* o8 = (u32x2*)orow + lane;
#pragma unroll
    for (int j = 0; j < 4; ++j) { const f32x4 gg = gr[64 * j]; u32x2 w; w.x = pk2(v[j].x * rstd * gg.x, v[j].y * rstd * gg.y); w.y = pk2(v[j].z * rstd * gg.z, v[j].w * rstd * gg.w); o8[64 * j] = w; }
}

constexpr int TR_IN = 16 * 72, TR_SQ = 16 * 32, TR_1 = 16 * 128, TR_2 = 64 * 32, TR_C1 = 32 * 8, TR_C2 = 4 * 8, TR_PW = 4 * 8;
constexpr int TR_PER_L = TR_IN + 4 * TR_SQ + TR_1 + TR_2 + 2 * TR_C1 + 2 * TR_C2 + TR_PW;
__device__ __forceinline__ void tr_dispatch(const Params& p, LAS float* scr, int l, int r, int lane) {
    unsigned char* wl = p.ws + WS_W + (size_t)l * WS_WL;
    if (r < TR_SQ) { tr_item(p.in[I_WK] + (size_t)l * DM * DM, DM, DM, DM, (bf16_t*)(wl + W_K), scr, r, lane); return; } r -= TR_SQ;
    if (r < TR_SQ) { tr_item(p.in[I_WV] + (size_t)l * DM * DM, DM, DM, DM, (bf16_t*)(wl + W_V), scr, r, lane); return; } r -= TR_SQ;
    if (r < TR_SQ) { tr_item(p.in[I_WO] + (size_t)l * DM * DM, DM, DM, DM, (bf16_t*)(wl + W_O), scr, r, lane); return; } r -= TR_SQ;
    if (r < TR_IN) { tr_item(p.in[I_WIN] + (size_t)l * DM * 2072, DM, 2072, DINP, (bf16_t*)(wl + W_IN), scr, r, lane, p.in[I_MIXPRE] + l * DM); return; } r -= TR_IN;
    if (r < TR_SQ) { tr_item(p.in[I_WOUT] + (size_t)l * DM * DM, DM, DM, DM, (bf16_t*)(wl + W_OUT), scr, r, lane); return; } r -= TR_SQ;
    if (r < TR_1) { tr_item(p.in[I_W1] + (size_t)l * DM * FF, DM, FF, FF, (bf16_t*)(wl + W_1), scr, r, lane, p.in[I_MLPPRE] + l * DM); return; } r -= TR_1;
    if (r < TR_2) { tr_item(p.in[I_W2] + (size_t)l * FF * DM, FF, DM, DM, (bf16_t*)(wl + W_2), scr, r, lane); return; } r -= TR_2;
    if (r < TR_C1) { tr_item(p.in[I_CKW1] + (size_t)l * 2048 * 256, 2048, 256, 256, (bf16_t*)(wl + W_CK1), scr, r, lane); return; } r -= TR_C1;
    if (r < TR_C1) { tr_item(p.in[I_CVW1] + (size_t)l * 2048 * 256, 2048, 256, 256, (bf16_t*)(wl + W_CV1), scr, r, lane); return; } r -= TR_C1;
    if (r < TR_C2) { tr_item(p.in[I_CKW2] + (size_t)l * 256 * 64, 256, 64, 256, (bf16_t*)(wl + W_CK2), scr, r, lane); return; } r -= TR_C2;
    if (r < TR_C2) { tr_item(p.in[I_CVW2] + (size_t)l * 256 * 64, 256, 64, 256, (bf16_t*)(wl + W_CV2), scr, r, lane); return; } r -= TR_C2;
    tr_item(p.in[I_CPW] + (size_t)l * 256 * 256, 256, 256, 256, (bf16_t*)(wl + W_CPW), scr, r, lane);
}
__device__ __forceinline__ void deferred_transposes(const Params& p, LAS unsigned char* lds, int bx, int G) {
    const int tid = opaque_tid(), lane = tid & 63, wave = tid >> 6;
    if (bx < 64) return;
    LAS float* scr = (LAS float*)(lds + wave * 16384);
    const int gw = (bx - 64) * 8 + wave, NGW = (G - 64) * 8;
    for (int it = gw; it < TR_PER_L - 3 * TR_SQ; it += NGW) tr_dispatch(p, scr, 1, 3 * TR_SQ + it, lane);
}

__device__ __forceinline__ void prologue_phase(const Params& p, LAS unsigned char* lds, int vcu, int G) {
    const int tid = opaque_tid(), lane = tid & 63, wave = tid >> 6;
    LAS float* scr = (LAS float*)(lds + wave * 16384);
    const int gw = vcu * 8 + wave, NGW = G * 8;
    unsigned char* ws = p.ws;
    constexpr int N_PRO = TR_PER_L + 3 * TR_SQ;
    for (int it = gw; it < N_PRO; it += NGW) { if (it < TR_PER_L) tr_dispatch(p, scr, 0, it, lane); else tr_dispatch(p, scr, 1, it - TR_PER_L, lane); }
    for (int e = vcu * 512 + tid; e < 2 * DM * DM / 4; e += G * 512) {
        const int l = e / (DM * DM / 4), r = e % (DM * DM / 4), k = r / (DM / 4);
        const f32x4 w = ((const f32x4*)(p.in[I_WQ] + (size_t)l * DM * DM))[r]; const float gk = p.in[I_XAPRE][l * DM + k];
        u32x2 o; o.x = pk2(w.x * gk, w.y * gk); o.y = pk2(w.z * gk, w.w * gk);
        ((u32x2*)(ws + WS_W + (size_t)l * WS_WL + W_Q))[r] = o;
    }
    for (int e = vcu * 512 + tid; e < 2 * 65536; e += G * 512) {
        const int l = e >> 16, n = (e >> 8) & 255, k = e & 255;
        float v = 0.f;
        if ((n >> 6) == (k >> 6)) v = p.in[I_POOLW][(size_t)l * 16384 + (n >> 6) * 4096 + (k & 63) * 64 + (n & 63)] * p.in[I_POOLS][l * 256 + n];
        ((bf16_t*)(ws + WS_W + (size_t)l * WS_WL + W_POOL))[n * 256 + k] = (bf16_t)f2bf(v);
    }
    for (int it = vcu; it < 16; it += G) {
        const int l = it >> 3, kv = (it >> 2) & 1, nc = it & 3;
        const float* pos = p.in[kv ? I_CVPOS : I_CKPOS] + (size_t)l * 2048;
        const float* w1 = p.in[kv ? I_CVW1 : I_CKW1] + (size_t)l * 2048 * 256;
        const int ks = tid >> 6, n = nc * 64 + (tid & 63);
        float a = 0.f;
        for (int k = ks * 256; k < ks * 256 + 256; ++k) a += pos[k] * w1[(size_t)k * 256 + n];
        LAS float* red = (LAS float*)(lds + 131072);
        red[ks * 64 + (tid & 63)] = a;
        __syncthreads();
        if (tid < 64) { float s = 0.f;
#pragma unroll
            for (int q = 0; q < 8; ++q) s += red[q * 64 + tid];
            ((float*)(ws + WS_W + (size_t)l * WS_WL + (kv ? W_CB1V : W_CB1K)))[nc * 64 + tid] = s; }
        __syncthreads();
    }
    for (int m = gw; m < 2 * NB * NMEM; m += NGW) { const int l = m / (NB * NMEM), r = m % (NB * NMEM);
        rms_row_to_bf16(p.in[I_MEM] + (size_t)r * DM, p.in[I_MEMG] + l * DM, (bf16_t*)(ws + WS_W + (size_t)l * WS_WL + W_MEMN) + (size_t)r * DM, lane); }
    for (int m = gw; m < MTOK; m += NGW) {
        const f32x4* xr = (const f32x4*)(p.in[I_X] + (size_t)m * DM) + lane; f32x4 v[4]; float sq = 0.f;
#pragma unroll
        for (int j = 0; j < 4; ++j) { v[j] = xr[64 * j]; sq += (v[j].x * v[j].x + v[j].y * v[j].y) + (v[j].z * v[j].z + v[j].w * v[j].w); }
        sq = wave_sum(sq);
        u32x2* o8 = (u32x2*)((bf16_t*)(ws + WS_XRES) + (size_t)m * DM) + lane;
#pragma unroll
        for (int j = 0; j < 4; ++j) { u32x2 w; w.x = pk2(v[j].x, v[j].y); w.y = pk2(v[j].z, v[j].w); o8[64 * j] = w; }
        if (lane == 0) ((f32x4*)(ws + WS_XB2))[m] = (f32x4){sq, 0.f, 0.f, 0.f};
    }
}

__device__ __forceinline__ void prep_phase(const Params& p, int l, LAS unsigned char* lds, int vcu, int G) {
    const int tid = opaque_tid(), lane = tid & 63, wave = tid >> 6;
    const bf16_t* PROJ = (const bf16_t*)(p.ws + WS_PROJ); bf16_t* ACT = (bf16_t*)(p.ws + WS_ACT);
    bf16_t* KCR = (bf16_t*)(p.ws + WS_KCRAW); bf16_t* VCR = (bf16_t*)(p.ws + WS_VCRAW);
    LAS bf16_t* hT = (LAS bf16_t*)lds;
    LAS float* cv = (LAS float*)(lds + 49152);
    const float* cw = p.in[I_CONVW] + (size_t)l * 31 * 256; const float* cb = p.in[I_CONVB] + l * 256;
    const float* lg = p.in[I_CLNG] + l * 256; const float* lb = p.in[I_CLNB] + l * 256;
    for (int u = vcu; u < MTOK / 64; u += G) {
        const int b = u >> 7, t0 = (u & 127) * 64; const size_t R0 = (size_t)b * SEQ + t0;
        for (int it = tid; it < 94 * 32; it += 512) { const int jr = it >> 5, ch = (it & 31) * 8; const int t = t0 - 30 + jr;
            u32x4 o = (u32x4){0u, 0u, 0u, 0u};
            if (t >= 0) { const bf16_t* rp = PROJ + ((size_t)b * SEQ + t) * DINP; const u32x4 a = *(const u32x4*)(rp + 256 + ch), gt = *(const u32x4*)(rp + 512 + ch);
#pragma unroll
                for (int e = 0; e < 4; ++e) { const unsigned aw = a[e], gw_ = gt[e];
                    const float a0 = __builtin_bit_cast(float, aw << 16), a1 = __builtin_bit_cast(float, aw & 0xffff0000u), g0 = __builtin_bit_cast(float, gw_ << 16), g1 = __builtin_bit_cast(float, gw_ & 0xffff0000u);
                    o[e] = pk2(a0 * __builtin_amdgcn_rcpf(1.f + __expf(-g0)), a1 * __builtin_amdgcn_rcpf(1.f + __expf(-g1))); } }
            *(LAS u32x4*)(hT + jr * 256 + ch) = o; }
        { LAS bf16_t* pT = (LAS bf16_t*)cv;
          for (int it = tid; it < 79 * 32; it += 512) { const int jr = it >> 5, ch = (it & 31) * 8; const int t = t0 - 15 + jr;
              u32x4 o = (u32x4){0u, 0u, 0u, 0u};
              if (t >= 0) o = *(const u32x4*)(PROJ + ((size_t)b * SEQ + t) * DINP + ch);
              *(LAS u32x4*)(pT + jr * 256 + ch) = o; } }
        for (int it = tid; it < 64 * 32; it += 512) { const int i = it >> 5, cc = it & 31; const int which = cc >> 4, g = (cc >> 3) & 1, d8 = (cc & 7) * 8;
            const u32x4 v = *(const u32x4*)(PROJ + (R0 + i) * DINP + 1280 + cc * 8);
            bf16_t* dst = (which ? VCR : KCR) + (((size_t)(b * 2 + g) * SEQ + t0 + i) * 64 + d8); *(u32x4*)dst = v; }
        __syncthreads();
        { const int c = tid & 255, half = tid >> 8; const int w = 2 << (c >> 6);
          LAS const bf16_t* pT = (LAS const bf16_t*)cv + c;
          float sum = 0.f; const int i0 = half * 32;
          for (int d = 1; d < w; ++d) sum += bf2f(pT[(15 + i0 - d) * 256]);
          for (int i = i0; i < i0 + 32; ++i) { const int t = t0 + i; const float ut = bf2f(pT[(15 + i) * 256]); sum += ut;
              const int cnt = (t + 1 < w) ? (t + 1) : w; const float d = sum / (float)cnt - ut;
              ACT[(R0 + i) * 512 + c] = (bf16_t)f2bf(d);
              sum -= bf2f(pT[(15 + i - w + 1) * 256]); } }
        __syncthreads();
        { const int c = tid & 255, half = tid >> 8; float wv[31];
#pragma unroll
          for (int k = 0; k < 31; ++k) wv[k] = cw[k * 256 + c];
          const float bias = cb[c];
#pragma unroll 1
          for (int pass = 0; pass < 2; ++pass) { const int i0 = half * 32 + pass * 16; float a[16];
#pragma unroll
              for (int i = 0; i < 16; ++i) a[i] = bias;
#pragma unroll
              for (int j = 0; j < 46; ++j) { const float hv = bf2f(hT[(i0 + j) * 256 + c]);
#pragma unroll
                  for (int i = 0; i < 16; ++i) if (j - i >= 0 && j - i <= 30) a[i] += wv[j - i] * hv; }
#pragma unroll
              for (int i = 0; i < 16; ++i) cv[(i0 + i) * 256 + c] = a[i]; } }
        __syncthreads();
        for (int ib = wave * 8; ib < wave * 8 + 8; ib += 4) { f32x4 x[4]; float s1[4], s2[4];
#pragma unroll
            for (int q = 0; q < 4; ++q) { x[q] = *(LAS f32x4*)(cv + (ib + q) * 256 + lane * 4); s1[q] = (x[q].x + x[q].y) + (x[q].z + x[q].w); }
#pragma unroll
            for (int q = 0; q < 4; ++q) s1[q] = wave_sum(s1[q]);
#pragma unroll
            for (int q = 0; q < 4; ++q) { x[q] = x[q] - s1[q] * (1.f / 256.f); s2[q] = (x[q].x * x[q].x + x[q].y * x[q].y) + (x[q].z * x[q].z + x[q].w * x[q].w); }
#pragma unroll
            for (int q = 0; q < 4; ++q) s2[q] = wave_sum(s2[q]);
            const f32x4 gg = *(const f32x4*)(lg + lane * 4), bb = *(const f32x4*)(lb + lane * 4);
#pragma unroll
            for (int q = 0; q < 4; ++q) { const float rs = 1.f / sqrtf(s2[q] * (1.f / 256.f) + EPS);
                f32x4 y = x[q] * rs * gg + bb;
#pragma unroll
                for (int e = 0; e < 4; ++e) y[e] = y[e] * __builtin_amdgcn_rcpf(1.f + __expf(-y[e]));
                u32x2 w; w.x = pk2(y.x, y.y); w.y = pk2(y.z, y.w);
                *(u32x2*)(ACT + (R0 + ib + q) * 512 + 256 + lane * 4) = w; } }
        __syncthreads();
    }
}

namespace nsa {
constexpr int KB0 = 0, VB0 = 24576, LUT_OFF = 49152, WSF_OFF = 51712, SEL_OFF = 52736, IMP_OFF = 53760, OST_OFF = 87040, IMP_PITCH = 129, LUT_PITCH = 132;
__device__ __forceinline__ int crow(int r, int hi) { return (r & 3) + 8 * (r >> 2) + 4 * hi; }
__device__ __forceinline__ int rel_bucket_dev(int n) {
    if (n < 16) return n;
    const float v = logf((float)n / 16.f) / 2.0794415416798357f * 16.f;
    const int b = 16 + (int)v; return b < 31 ? b : 31;
}
__device__ __forceinline__ s16x4 vtr(LAS const char* p) { return __builtin_bit_cast(s16x4, __builtin_amdgcn_ds_read_tr16_b64_v4i16((LAS s16x4*)p)); }

struct TileRegs { u32x4 k, v; };
__device__ __forceinline__ void gload(TileRegs& R, const bf16_t* Kg, const bf16_t* Vg, int pitch, int tile, int wid, int lane) {
    const char* kt = (const char*)(Kg + (size_t)tile * 64 * pitch); const char* vt = (const char*)(Vg + (size_t)tile * 64 * pitch);
    const unsigned ko = (unsigned)(lane * pitch + wid * 8) * 2u;
    const unsigned vo = (unsigned)((16 * (wid & 3) + (lane >> 2)) * pitch + (wid >> 2) * 32 + (lane & 3) * 8) * 2u;
    R.k = *(const u32x4*)(kt + ko);
    R.v = *(const u32x4*)(vt + vo);
}
__device__ __forceinline__ void lstore(const TileRegs& R, LAS unsigned char* lds, int buf, int wid, int lane) {
    *(LAS u32x4*)(lds + KB0 + buf * 8192 + wid * 1024 + lane * 16) = R.k;
    *(LAS u32x4*)(lds + VB0 + buf * 8192 + wid * 1024 + lane * 16) = R.v;
}

template <int BR>
__device__ __forceinline__ void tile_compute(LAS unsigned char* lds, int buf, const bf16x8 (&qr)[4], f32x16 (&o)[2], float& m, float& l, float linv,
                                             int Dbase, bool general, float farb, LAS const float* lutr, bool rowvalid, int tok, int mbase, float& carry, int lane, int wid) {
    const int r32 = lane & 31, hi = lane >> 5;
    constexpr int KS = (BR <= 1) ? 16 : 1;
    f32x16 p0 = {}, p1 = {};
    { LAS const char* kb = (LAS const char*)(lds + KB0 + buf * 8192 + hi * 1024 + r32 * 16);
#pragma unroll
      for (int d0 = 0; d0 < 4; ++d0) { const bf16x8 b0 = *(LAS const bf16x8*)(kb + d0 * 2048), b1 = *(LAS const bf16x8*)(kb + d0 * 2048 + 512);
          p0 = __builtin_amdgcn_mfma_f32_32x32x16_bf16(b0, qr[d0], p0, 0, 0, 0); p1 = __builtin_amdgcn_mfma_f32_32x32x16_bf16(b1, qr[d0], p1, 0, 0, 0); } }
    if (general) {
        asm volatile("" : "+v"(Dbase));
#pragma unroll
        for (int r4 = 0; r4 < 16; r4 += 4) {
            float b0[4], b1[4];
#pragma unroll
            for (int e = 0; e < 4; ++e) { const int kv = crow(r4 + e, hi); const int d0 = Dbase - KS * kv, d1 = d0 - KS * 32;
                const int i0 = d0 < 0 ? 0 : (d0 > 128 ? 128 : d0), i1 = d1 < 0 ? 0 : (d1 > 128 ? 128 : d1);
                b0[e] = lutr[i0]; b1[e] = lutr[i1]; }
            asm volatile("" : "+v"(b0[0]), "+v"(b0[1]), "+v"(b0[2]), "+v"(b0[3]), "+v"(b1[0]), "+v"(b1[1]), "+v"(b1[2]), "+v"(b1[3]));
#pragma unroll
            for (int e = 0; e < 4; ++e) { const int r = r4 + e; const int kv = crow(r, hi); const int d0 = Dbase - KS * kv, d1 = d0 - KS * 32;
                bool v0 = d0 >= 0 && rowvalid, v1 = d1 >= 0 && rowvalid; if (BR == 3) { v0 = v0 && d0 < 512; v1 = v1 && d1 < 512; }
                p0[r] = v0 ? p0[r] + b0[e] : NEGV; p1[r] = v1 ? p1[r] + b1[e] : NEGV; }
        }
    } else {
#pragma unroll
        for (int r = 0; r < 16; ++r) { p0[r] = rowvalid ? p0[r] + farb : NEGV; p1[r] = rowvalid ? p1[r] + farb : NEGV; }
    }
    if (BR == 1) {
#pragma unroll
        for (int r = 0; r < 16; ++r) { p0[r] = ex2(p0[r] - m) * linv; p1[r] = ex2(p1[r] - m) * linv; }
        LAS float* IMP = (LAS float*)(lds + IMP_OFF) + tok * IMP_PITCH;
        float px[4], py[4];
#pragma unroll
        for (int k = 0; k < 4; ++k) { px[k] = xch32(p0[4 * k + 3], hi); py[k] = xch32(p1[4 * k + 3], hi); }
#pragma unroll
        for (int k = 0; k < 4; ++k) {
            const float pv0 = hi ? px[k] : (k == 0 ? carry : px[k > 0 ? k - 1 : 0]);
            const float pv1 = hi ? py[k] : (k == 0 ? px[3] : py[k > 0 ? k - 1 : 0]);
            float g0 = (p0[4 * k] + p0[4 * k + 1]) + (p0[4 * k + 2] + p0[4 * k + 3]) + pv0;
            float g1 = (p1[4 * k] + p1[4 * k + 1]) + (p1[4 * k + 2] + p1[4 * k + 3]) + pv1;
            g0 += shx<1>(g0); g0 += shx<2>(g0); g1 += shx<1>(g1); g1 += shx<2>(g1);
            if ((r32 & 3) == 0) { const int mi = mbase + 2 * k + hi; IMP[mi] = g0; IMP[mi + 8] = g1; }
        }
        carry = py[3];
    } else {
        float mx = NEGV;
#pragma unroll
        for (int r = 0; r < 16; ++r) mx = fmaxf(mx, fmaxf(p0[r], p1[r]));
        mx = max32(mx);
        const float mn = fmaxf(m, mx); const float alpha = ex2(m - mn); m = mn;
        float sm = 0.f;
#pragma unroll
        for (int r = 0; r < 16; ++r) { p0[r] = ex2(p0[r] - mn); p1[r] = ex2(p1[r] - mn); sm += p0[r] + p1[r]; }
        l = l * alpha + sm;
        if (BR >= 2) {
            if (__any(alpha != 1.f)) {
                LAS float* wsf = (LAS float*)(lds + WSF_OFF) + wid * 32;
                if (hi == 0) wsf[r32] = alpha;
                asm volatile("s_waitcnt lgkmcnt(0)" ::: "memory");
#pragma unroll
                for (int r = 0; r < 16; ++r) { const float a = wsf[crow(r, hi)]; o[0][r] *= a; o[1][r] *= a; }
                asm volatile("s_waitcnt lgkmcnt(0)" ::: "memory");
            }
        }
    }
    if (BR >= 1) {
        u32x4 pw[4];
        pw[0] = (u32x4){cvt_pk_bf16(p0[0], p0[1]), cvt_pk_bf16(p0[2], p0[3]), cvt_pk_bf16(p0[4], p0[5]), cvt_pk_bf16(p0[6], p0[7])};
        pw[1] = (u32x4){cvt_pk_bf16(p0[8], p0[9]), cvt_pk_bf16(p0[10], p0[11]), cvt_pk_bf16(p0[12], p0[13]), cvt_pk_bf16(p0[14], p0[15])};
        pw[2] = (u32x4){cvt_pk_bf16(p1[0], p1[1]), cvt_pk_bf16(p1[2], p1[3]), cvt_pk_bf16(p1[4], p1[5]), cvt_pk_bf16(p1[6], p1[7])};
        pw[3] = (u32x4){cvt_pk_bf16(p1[8], p1[9]), cvt_pk_bf16(p1[10], p1[11]), cvt_pk_bf16(p1[12], p1[13]), cvt_pk_bf16(p1[14], p1[15])};
        LAS const char* vp = (LAS const char*)(lds + VB0 + buf * 8192 + ((lane >> 4) & 1) * 32 + (lane & 3) * 8 + (4 * hi + ((lane & 15) >> 2)) * 64);
#pragma unroll
        for (int d0 = 0; d0 < 2; ++d0)
#pragma unroll
            for (int ks = 0; ks < 4; ++ks) { const s16x4 lo = vtr(vp + d0 * 4096 + ks * 1024), hh = vtr(vp + d0 * 4096 + ks * 1024 + 512);
                const bf16x8 vf = (bf16x8){lo[0], lo[1], lo[2], lo[3], hh[0], hh[1], hh[2], hh[3]};
                o[d0] = __builtin_amdgcn_mfma_f32_32x32x16_bf16(__builtin_bit_cast(bf16x8, pw[ks]), vf, o[d0], 0, 0, 0); }
    }
}

__device__ __forceinline__ void accum_branch(LAS unsigned char* lds, f32x16 (&o)[2], float fac, bool first, int lane, int wid) {
    const int r32 = lane & 31, hi = lane >> 5;
    LAS float* wsf = (LAS float*)(lds + WSF_OFF) + wid * 32;
    LAS float* st = (LAS float*)(lds + OST_OFF) + wid * 2048 + lane;
    if (hi == 0) wsf[r32] = fac;
    asm volatile("s_waitcnt lgkmcnt(0)" ::: "memory");
#pragma unroll
    for (int r = 0; r < 16; ++r) { const float a = wsf[crow(r, hi)];
        float v0 = o[0][r] * a, v1 = o[1][r] * a;
        if (!first) { v0 += st[(r * 2) * 64]; v1 += st[(r * 2 + 1) * 64]; }
        st[(r * 2) * 64] = v0; st[(r * 2 + 1) * 64] = v1; }
    asm volatile("s_waitcnt lgkmcnt(0)" ::: "memory");
}

__device__ __forceinline__ void qk_tile(LAS unsigned char* lds, int slot, const bf16x8 (&qr)[4], float ci, f32x16& p0, f32x16& p1, int r32, int hi) {
#pragma unroll
    for (int r = 0; r < 16; ++r) { p0[r] = ci; p1[r] = ci; }
    LAS const char* kb = (LAS const char*)(lds + KB0 + slot * 8192 + hi * 1024 + r32 * 16);
#pragma unroll
    for (int d0 = 0; d0 < 4; ++d0) { const bf16x8 b0 = *(LAS const bf16x8*)(kb + d0 * 2048), b1 = *(LAS const bf16x8*)(kb + d0 * 2048 + 512);
        p0 = __builtin_amdgcn_mfma_f32_32x32x16_bf16(b0, qr[d0], p0, 0, 0, 0); p1 = __builtin_amdgcn_mfma_f32_32x32x16_bf16(b1, qr[d0], p1, 0, 0, 0); }
}
__device__ __forceinline__ unsigned pkbf(float lo, float hi) { typedef __bf16 bf2 __attribute__((ext_vector_type(2))); f32x2 v = {lo, hi}; return __builtin_bit_cast(unsigned, __builtin_convertvector(v, bf2)); }
__device__ __forceinline__ void pv_tile(LAS unsigned char* lds, int slot, const f32x16& p0, const f32x16& p1, f32x16 (&o)[2], int lane, int hi) {
    u32x4 pw[4];
    pw[0] = (u32x4){pkbf(p0[0], p0[1]), pkbf(p0[2], p0[3]), pkbf(p0[4], p0[5]), pkbf(p0[6], p0[7])};
    pw[1] = (u32x4){pkbf(p0[8], p0[9]), pkbf(p0[10], p0[11]), pkbf(p0[12], p0[13]), pkbf(p0[14], p0[15])};
    pw[2] = (u32x4){pkbf(p1[0], p1[1]), pkbf(p1[2], p1[3]), pkbf(p1[4], p1[5]), pkbf(p1[6], p1[7])};
    pw[3] = (u32x4){pkbf(p1[8], p1[9]), pkbf(p1[10], p1[11]), pkbf(p1[12], p1[13]), pkbf(p1[14], p1[15])};
    LAS const char* vp = (LAS const char*)(lds + VB0 + slot * 8192 + ((lane >> 4) & 1) * 32 + (lane & 3) * 8 + (4 * hi + ((lane & 15) >> 2)) * 64);
    __builtin_amdgcn_sched_barrier(0);
#pragma unroll
    for (int d0 = 0; d0 < 2; ++d0) {
#pragma unroll
        for (int ks = 0; ks < 4; ++ks) { const s16x4 lo = vtr(vp + d0 * 4096 + ks * 1024), hh = vtr(vp + d0 * 4096 + ks * 1024 + 512);
            const bf16x8 vf = (bf16x8){lo[0], lo[1], lo[2], lo[3], hh[0], hh[1], hh[2], hh[3]};
            o[d0] = __builtin_amdgcn_mfma_f32_32x32x16_bf16(__builtin_bit_cast(bf16x8, pw[ks]), vf, o[d0], 0, 0, 0); }
        __builtin_amdgcn_sched_barrier(0);
    }
}
template <int BR>
__device__ __forceinline__ void pipe_step(LAS unsigned char* lds, int k, int n, int qt, int slot_c, int slot_n, bool act_c, bool& act_n,
                                          f32x16& sc0, f32x16& sc1, f32x16& sn0, f32x16& sn1, const bf16x8 (&qr)[4], f32x16 (&o)[2], float& mref, float& l,
                                          LAS const float* lutr, float farb, LAS const unsigned* selw, LAS float* wsf, int tok, int lane) {
    const int r32 = lane & 31, hi = lane >> 5;
    const int tile = qt - k;
    float ci = 0.f; act_n = false;
    if (k + 1 < n) {
        const int tn = tile - 1, dn = k + 1;
        const bool gen_n = dn <= 2 || (BR == 3 && dn >= 8);
        bool rv = true; if (BR == 2) rv = (selw[tn >> 5] >> (tn & 31)) & 1u;
        act_n = (BR == 3) || __any(rv);
        ci = (gen_n ? 0.f : (rv ? farb : NEGV)) - mref;
    }
    if (act_n) {
        bf16x8 kf[8];
        LAS const char* kb = (LAS const char*)(lds + KB0 + slot_n * 8192 + hi * 1024 + r32 * 16);
#pragma unroll
        for (int d0 = 0; d0 < 4; ++d0) { kf[2 * d0] = *(LAS const bf16x8*)(kb + d0 * 2048); kf[2 * d0 + 1] = *(LAS const bf16x8*)(kb + d0 * 2048 + 512); }
#pragma unroll
        for (int r = 0; r < 16; ++r) { sn0[r] = ci; sn1[r] = ci; }
        __builtin_amdgcn_sched_barrier(0);
#pragma unroll
        for (int i = 0; i < 8; ++i) {
            if (i & 1) sn1 = __builtin_amdgcn_mfma_f32_32x32x16_bf16(kf[i], qr[i >> 1], sn1, 0, 0, 0);
            else       sn0 = __builtin_amdgcn_mfma_f32_32x32x16_bf16(kf[i], qr[i >> 1], sn0, 0, 0, 0); }
    } else {
#pragma unroll
        for (int r = 0; r < 16; ++r) { sn0[r] = 0.f; sn1[r] = 0.f; }
    }
    if (act_c) {
        const bool gen = k <= 2 || (BR == 3 && k >= 8);
        if (gen) {
            bool rv = true; if (BR == 2) rv = (selw[tile >> 5] >> (tile & 31)) & 1u;
            int Dbase = 64 * k + tok; asm volatile("" : "+v"(Dbase));
#pragma unroll
            for (int r4 = 0; r4 < 16; r4 += 4) {
                float b0[4], b1[4];
#pragma unroll
                for (int e = 0; e < 4; ++e) { const int kv = crow(r4 + e, hi); const int d0 = Dbase - kv, d1 = d0 - 32;
                    const int i0 = d0 < 0 ? 0 : (d0 > 128 ? 128 : d0), i1 = d1 < 0 ? 0 : (d1 > 128 ? 128 : d1);
                    b0[e] = lutr[i0]; b1[e] = lutr[i1]; }
                asm volatile("" : "+v"(b0[0]), "+v"(b0[1]), "+v"(b0[2]), "+v"(b0[3]), "+v"(b1[0]), "+v"(b1[1]), "+v"(b1[2]), "+v"(b1[3]));
#pragma unroll
                for (int e = 0; e < 4; ++e) { const int r = r4 + e; const int kv = crow(r, hi); const int d0 = Dbase - kv, d1 = d0 - 32;
                    bool v0 = d0 >= 0 && rv, v1 = d1 >= 0 && rv; if (BR == 3) { v0 = v0 && d0 < 512; v1 = v1 && d1 < 512; }
                    sc0[r] = v0 ? sc0[r] + b0[e] : NEGV; sc1[r] = v1 ? sc1[r] + b1[e] : NEGV; }
            }
        }
        LAS const char* vp = (LAS const char*)(lds + VB0 + slot_c * 8192 + ((lane >> 4) & 1) * 32 + (lane & 3) * 8 + (4 * hi + ((lane & 15) >> 2)) * 64);
        s16x4 va[4], vb[4];
#pragma unroll
        for (int ks = 0; ks < 4; ++ks) { va[ks] = vtr(vp + ks * 1024); vb[ks] = vtr(vp + ks * 1024 + 512); }
        float rm = fmaxf(fmaxf(sc0[0], sc0[1]), sc1[0]);
        { float rb = fmaxf(fmaxf(sc0[2], sc0[3]), sc1[1]); rm = fmaxf(fmaxf(rm, sc1[2]), sc1[3]);
#pragma unroll
          for (int r = 4; r < 16; r += 4) { rm = fmaxf(fmaxf(rm, sc0[r]), sc0[r + 1]); rb = fmaxf(fmaxf(rb, sc0[r + 2]), sc0[r + 3]); rm = fmaxf(fmaxf(rm, sc1[r]), sc1[r + 1]); rb = fmaxf(fmaxf(rb, sc1[r + 2]), sc1[r + 3]); }
          rm = fmaxf(rm, rb); }
        rm = max32(rm);
        const bool need = (k == 0) || rm > 8.f;
        if (__any(need)) {
            const float dl = need ? rm : 0.f;
            mref += dl;
#pragma unroll
            for (int r = 0; r < 16; ++r) { sc0[r] -= dl; sc1[r] -= dl; }
            if (act_n) {
#pragma unroll
                for (int r = 0; r < 16; ++r) { sn0[r] -= dl; sn1[r] -= dl; }
            }
            const float alpha = (k == 0) ? 1.f : ex2(-dl); l *= alpha;
            if (hi == 0) wsf[r32] = alpha;
            asm volatile("s_waitcnt lgkmcnt(0)" ::: "memory");
#pragma unroll
            for (int r = 0; r < 16; ++r) { const float a = wsf[crow(r, hi)]; o[0][r] *= a; o[1][r] *= a; }
            asm volatile("s_waitcnt lgkmcnt(0)" ::: "memory");
        }
        float sm0 = 0.f, sm1 = 0.f;
#pragma unroll
        for (int r = 0; r < 16; r += 2) { sc0[r] = ex2(sc0[r]); sc0[r + 1] = ex2(sc0[r + 1]); sc1[r] = ex2(sc1[r]); sc1[r + 1] = ex2(sc1[r + 1]); sm0 += sc0[r] + sc0[r + 1]; sm1 += sc1[r] + sc1[r + 1]; }
        l += sm0 + sm1;
        u32x4 pw[4];
        pw[0] = (u32x4){pkbf(sc0[0], sc0[1]), pkbf(sc0[2], sc0[3]), pkbf(sc0[4], sc0[5]), pkbf(sc0[6], sc0[7])};
        pw[1] = (u32x4){pkbf(sc0[8], sc0[9]), pkbf(sc0[10], sc0[11]), pkbf(sc0[12], sc0[13]), pkbf(sc0[14], sc0[15])};
        pw[2] = (u32x4){pkbf(sc1[0], sc1[1]), pkbf(sc1[2], sc1[3]), pkbf(sc1[4], sc1[5]), pkbf(sc1[6], sc1[7])};
        pw[3] = (u32x4){pkbf(sc1[8], sc1[9]), pkbf(sc1[10], sc1[11]), pkbf(sc1[12], sc1[13]), pkbf(sc1[14], sc1[15])};
        __builtin_amdgcn_sched_barrier(0);
        s16x4 vc[4], vd[4];
#pragma unroll
        for (int ks = 0; ks < 4; ++ks) { vc[ks] = vtr(vp + 4096 + ks * 1024); vd[ks] = vtr(vp + 4096 + ks * 1024 + 512); }
#pragma unroll
        for (int ks = 0; ks < 4; ++ks) { const bf16x8 vf = (bf16x8){va[ks][0], va[ks][1], va[ks][2], va[ks][3], vb[ks][0], vb[ks][1], vb[ks][2], vb[ks][3]};
            o[0] = __builtin_amdgcn_mfma_f32_32x32x16_bf16(__builtin_bit_cast(bf16x8, pw[ks]), vf, o[0], 0, 0, 0); }
        __builtin_amdgcn_sched_barrier(0);
#pragma unroll
        for (int ks = 0; ks < 4; ++ks) { const bf16x8 vf = (bf16x8){vc[ks][0], vc[ks][1], vc[ks][2], vc[ks][3], vd[ks][0], vd[ks][1], vd[ks][2], vd[ks][3]};
            o[1] = __builtin_amdgcn_mfma_f32_32x32x16_bf16(__builtin_bit_cast(bf16x8, pw[ks]), vf, o[1], 0, 0, 0); }
    }
}
template <int BR>
__device__ __forceinline__ void run_pipe(LAS unsigned char* lds, const bf16_t* Kg, const bf16_t* Vg, int n, const bf16x8 (&qr)[4], f32x16 (&o)[2], float& lout,
                                         int qt, int tok, int head, int lane, int wid) {
    const int r32 = lane & 31, hi = lane >> 5;
    LAS const float* lutr = (LAS const float*)(lds + LUT_OFF) + head * LUT_PITCH;
    const float farb = lutr[128];
    LAS const unsigned* selw = (LAS const unsigned*)(lds + SEL_OFF) + tok * 4;
    LAS float* wsf = (LAS float*)(lds + WSF_OFF) + wid * 32;
    TileRegs R;
    gload(R, Kg, Vg, DINP, qt, wid, lane); lstore(R, lds, 0, wid, lane);
    if (n > 1) { gload(R, Kg, Vg, DINP, qt - 1, wid, lane); lstore(R, lds, 1, wid, lane); }
    if (n > 2) gload(R, Kg, Vg, DINP, qt - 2, wid, lane);
    __syncthreads();
    float mref = 0.f, l = 0.f;
    f32x16 sa0, sa1, sb0, sb1;
    qk_tile(lds, 0, qr, 0.f, sa0, sa1, r32, hi);
    sb0 = sa0; sb1 = sa1;
    bool act_c = true; int slot_c = 0;
    for (int k = 0; k < n; k += 2) {
        bool act_n;
        int slot_n = slot_c == 2 ? 0 : slot_c + 1;
        pipe_step<BR>(lds, k, n, qt, slot_c, slot_n, act_c, act_n, sa0, sa1, sb0, sb1, qr, o, mref, l, lutr, farb, selw, wsf, tok, lane);
        if (k + 2 < n) lstore(R, lds, slot_n == 2 ? 0 : slot_n + 1, wid, lane);
        if (k + 3 < n) gload(R, Kg, Vg, DINP, qt - k - 3, wid, lane);
        __syncthreads();
        act_c = act_n; slot_c = slot_n;
        if (k + 1 >= n) break;
        slot_n = slot_c == 2 ? 0 : slot_c + 1;
        pipe_step<BR>(lds, k + 1, n, qt, slot_c, slot_n, act_c, act_n, sb0, sb1, sa0, sa1, qr, o, mref, l, lutr, farb, selw, wsf, tok, lane);
        if (k + 3 < n) lstore(R, lds, slot_n == 2 ? 0 : slot_n + 1, wid, lane);
        if (k + 4 < n) gload(R, Kg, Vg, DINP, qt - k - 4, wid, lane);
        __syncthreads();
        act_c = act_n; slot_c = slot_n;
    }
    lout = l;
}

template <int BR>
__device__ __forceinline__ void run_branch(LAS unsigned char* lds, const bf16_t* Kg, const bf16_t* Vg, int pitch, int first, int step, int n,
                                           const bf16x8 (&qr)[4], f32x16 (&o)[2], float& m, float& l, float linv,
                                           int t0, int qt, int tok, int head, int lane, int wid) {
    TileRegs R; float carry = 0.f;
    gload(R, Kg, Vg, pitch, first, wid, lane); lstore(R, lds, 0, wid, lane);
    __syncthreads();
    LAS const float* lutr = (LAS const float*)(lds + LUT_OFF) + head * LUT_PITCH;
    const float farb = lutr[128];
    LAS const unsigned* selw = (LAS const unsigned*)(lds + SEL_OFF) + tok * 4;
    for (int k = 0; k < n; ++k) {
        const int tile = first + k * step;
        if (k + 1 < n) gload(R, Kg, Vg, pitch, tile + step, wid, lane);
        int Dbase; bool general; bool rowvalid = true;
        if (BR <= 1) { Dbase = t0 + tok - 31 - 16 * 64 * tile; general = (t0 - 16 * (64 * tile + 63) - 31) < 128; }
        else { Dbase = 64 * (qt - tile) + tok; general = (qt - tile) <= 2 || (BR == 3 && (qt - tile) >= 8); }
        if (BR == 2) rowvalid = (selw[tile >> 5] >> (tile & 31)) & 1u;
        if (BR != 2 || __any(rowvalid))
            tile_compute<BR>(lds, k & 1, qr, o, m, l, linv, Dbase, general, farb, lutr, rowvalid, tok, tile * 16, carry, lane, wid);
        if (k + 1 < n) lstore(R, lds, (k + 1) & 1, wid, lane);
        __syncthreads();
    }
}

__device__ __forceinline__ void nsa_unit(const Params& p, int l, LAS unsigned char* lds, int b, int g, int qt) {
    const int tid = opaque_tid(), lane = tid & 63, wid = __builtin_amdgcn_readfirstlane(tid >> 6), r32 = lane & 31, hi = lane >> 5;
    const bf16_t* PROJ = (const bf16_t*)(p.ws + WS_PROJ);
    const bf16_t* KC = (const bf16_t*)(p.ws + WS_KC) + (size_t)(b * 2 + g) * 512 * 256;
    const bf16_t* VC = (const bf16_t*)(p.ws + WS_VC) + (size_t)(b * 2 + g) * 512 * 256;
    bf16_t* CAT = (bf16_t*)(p.ws + WS_CAT);
    const int t0 = qt * 64; const size_t R0 = (size_t)b * SEQ;
    const int q = wid * 32 + r32, tok = q >> 2, head = q & 3;
    if (tid < 256) ((LAS unsigned*)(lds + SEL_OFF))[tid] = 0u;
    const bf16_t* qrow = PROJ + (R0 + t0 + tok) * DINP;
    bf16x8 qr[4];
#pragma unroll
    for (int d0 = 0; d0 < 4; ++d0) qr[d0] = *(const bf16x8*)(qrow + 768 + (g * 4 + head) * 64 + d0 * 16 + hi * 8);
    LAS float* gslot = (LAS float*)(lds + 153600) + (wid * 64 + lane) * 3;
#pragma unroll
    for (int br = 0; br < 3; ++br) gslot[br] = __builtin_amdgcn_rcpf(1.f + __expf(-bf2f(qrow[2048 + (g * 4 + head) * 3 + br])));
    __syncthreads();
    f32x16 o[2];
    const int nct = (4 * qt + 3 + 63) / 64;
    float mc = NEGV, lc = 0.f;
    o[0] = f32x16{}; o[1] = f32x16{};
    run_branch<0>(lds, KC, VC, 256, 0, 1, nct, qr, o, mc, lc, 0.f, t0, qt, tok, head, lane, wid);
    lc = sum32(lc);
    const float linvc = (mc > -1e29f && lc > 0.f) ? 1.f / lc : 0.f;
    { float md = 0.f, ld = 0.f; float mcc = mc;
      run_branch<1>(lds, KC, VC, 256, 0, 1, nct, qr, o, mcc, ld, linvc, t0, qt, tok, head, lane, wid); (void)md; }
    accum_branch(lds, o, ((LAS float*)(lds + 153600))[(wid * 64 + lane) * 3 + 0], true, lane, wid);
    __syncthreads();
    { LAS float* G = (LAS float*)(lds + IMP_OFF); LAS unsigned* selw = (LAS unsigned*)(lds + SEL_OFF);
      const int i = tid >> 3, sub = tid & 7; const int cur = qt;
      if (cur < 16) { if (sub < 4) { unsigned ones = 0xffffffffu; asm volatile("" : "+v"(ones)); selw[i * 4 + sub] = ones; } }
      else {
          for (int mm = 0; mm < 16; ++mm) { const int j = sub + 8 * mm; if (j <= cur) { float sc;
              if (j == 0 || j == cur || j == cur - 1) G[i * IMP_PITCH + j] = 1e30f; } }
          __syncthreads();
          unsigned long long kj[16];
#pragma unroll
          for (int mm = 0; mm < 16; ++mm) { const int j = sub + 8 * mm;
              kj[mm] = (j <= cur) ? (((unsigned long long)__float_as_uint(G[i * IMP_PITCH + j]) << 7) | (unsigned)(127 - j)) : 0ull; }
          unsigned long long T = 0ull;
          for (int bit = 38; bit >= 0; --bit) { const unsigned long long trial = T | (1ull << bit); int cnt = 0;
#pragma unroll
              for (int mm = 0; mm < 16; ++mm) cnt += (kj[mm] >= trial) ? 1 : 0;
              cnt += shxi<1>(cnt); cnt += shxi<2>(cnt); cnt += shxi<4>(cnt);
              if (cnt >= 16) T = trial; }
#pragma unroll
          for (int mm = 0; mm < 16; ++mm) { const int j = sub + 8 * mm; if (j <= cur && kj[mm] >= T) atomicOr((unsigned*)&selw[i * 4 + (j >> 5)], 1u << (j & 31)); }
      } }
    __syncthreads();
    { float ms = NEGV, ls = 0.f; o[0] = f32x16{}; o[1] = f32x16{};
      run_pipe<2>(lds, PROJ + R0 * DINP + 1536 + g * 64, PROJ + R0 * DINP + 1664 + g * 64, qt + 1, qr, o, ls, qt, tok, head, lane, wid); (void)ms;
      ls = sum32(ls);
      accum_branch(lds, o, ((LAS float*)(lds + 153600))[(wid * 64 + lane) * 3 + 1] / ls, false, lane, wid); }
    { float mw = NEGV, lw = 0.f; o[0] = f32x16{}; o[1] = f32x16{};
      const int nw = qt + 1 < 9 ? qt + 1 : 9;
      run_pipe<3>(lds, PROJ + R0 * DINP + 1792 + g * 64, PROJ + R0 * DINP + 1920 + g * 64, nw, qr, o, lw, qt, tok, head, lane, wid); (void)mw;
      lw = sum32(lw);
      accum_branch(lds, o, ((LAS float*)(lds + 153600))[(wid * 64 + lane) * 3 + 2] / lw, false, lane, wid); }
    { int l2 = lane; asm volatile("" : "+v"(l2));
      const int r32s = l2 & 31, his = l2 >> 5;
      LAS const float* st = (LAS const float*)(lds + OST_OFF) + wid * 2048 + l2;
      LAS bf16_t* T = (LAS bf16_t*)(lds + KB0 + wid * 4096);
#pragma unroll
      for (int r = 0; r < 16; ++r) { const int row = crow(r, his);
          T[row * 64 + r32s] = (bf16_t)f2bf(st[(r * 2) * 64]); T[row * 64 + 32 + r32s] = (bf16_t)f2bf(st[(r * 2 + 1) * 64]); }
      asm volatile("s_waitcnt lgkmcnt(0)" ::: "memory");
#pragma unroll
      for (int i = 0; i < 4; ++i) { const int row = i * 8 + (l2 >> 3), ch = l2 & 7; const u32x4 v = *(LAS const u32x4*)(T + row * 64 + ch * 8);
          const int qq = wid * 32 + row; const int tk = qq >> 2, hd = qq & 3;
          *(u32x4*)(CAT + (R0 + t0 + tk) * DM + 512 + (g * 4 + hd) * 64 + ch * 8) = v; }
      asm volatile("s_waitcnt lgkmcnt(0)" ::: "memory"); }
    __syncthreads();
}

__device__ __forceinline__ void nsa_phase(const Params& p, int l, LAS unsigned char* lds, int vcu, int G) {
    for (int v = vcu; v < 256; v += G) {
        const int bg = v >> 4, s = v & 15;
        { const int tid = opaque_tid(); const int g = bg & 1; LAS float* lut = (LAS float*)(lds + LUT_OFF);
          __syncthreads();
          for (int e = tid; e < 4 * 129; e += 512) { const int r = e / 129, d = e % 129; const int bk = d >= 128 ? 31 : rel_bucket_dev(d);
              lut[r * LUT_PITCH + d] = p.in[I_RELB][bk * 8 + g * 4 + r] * LOG2E; }
          __syncthreads(); }
        for (int i = 0; i < 8; ++i) { const int qt = (i >> 1) * 32 + ((i & 1) ? 31 - s : s); nsa_unit(p, l, lds, bg >> 1, bg & 1, qt); }
    }
}
}


#define XB_TMO      128
#define XB_XCNT(j)  (256  + 64 * (j))
#define XB_XSUB(j)  (1280 + 64 * (j))
#define XB_XGEN(j)  (2304 + 64 * (j))
#define XB_TOP      3328
#define XB_TOPGEN   3392
#define XCD_BAR_WORDS 3456
#define XB_SPIN_CAP (1u << 22)
__device__ __forceinline__ unsigned xb_ld(unsigned* p)              { return __hip_atomic_load(p, __ATOMIC_RELAXED, __HIP_MEMORY_SCOPE_AGENT); }
__device__ __forceinline__ unsigned xb_add(unsigned* p, unsigned v) { return __hip_atomic_fetch_add(p, v, __ATOMIC_RELAXED, __HIP_MEMORY_SCOPE_AGENT); }
__device__ __forceinline__ unsigned xb_xcc_id() { return (unsigned)__builtin_amdgcn_s_getreg((3 << 11) | 20) & 0xFu; }
#define XB_SPIN(cond, bar) do { unsigned _sp = 0; while (cond) { __builtin_amdgcn_s_sleep(1); \
    if ((++_sp & 255u) == 0u) { if (xb_ld(&(bar)[XB_TMO])) break; if (_sp > XB_SPIN_CAP) { atomicAdd(&(bar)[XB_TMO], 1u); break; } } } } while (0)
struct XcdBarrier { unsigned* bar; unsigned x; volatile LAS unsigned* st; };
__device__ __forceinline__ XcdBarrier xcd_barrier_post(unsigned* bar, volatile LAS unsigned* st) {
    XcdBarrier b; b.bar = bar; b.x = xb_xcc_id(); b.st = st;
    if (opaque_tid() == 0) (void)xb_add(&bar[XB_XCNT(b.x)], 1u);
    return b;
}
__device__ __forceinline__ void xcd_barrier_complete(unsigned* bar, unsigned x, unsigned& nloc, unsigned& nx) {
    const unsigned G = gridDim.x * gridDim.y * gridDim.z;
    unsigned sum, cnt, mine, sp = 0u;
    for (;;) {
        sum = 0u; cnt = 0u; mine = 0u;
#pragma unroll
        for (unsigned j = 0; j < 16; ++j) { const unsigned c = xb_ld(&bar[XB_XCNT(j)]); sum += c; cnt += (c > 0u) ? 1u : 0u; mine = (j == x) ? c : mine; }
        if (sum == G) break;
        __builtin_amdgcn_s_sleep(1);
        if ((++sp & 255u) == 0u) { if (xb_ld(&bar[XB_TMO])) break; if (sp > XB_SPIN_CAP) { atomicAdd(&bar[XB_TMO], 1u); break; } }
    }
    nloc = mine > 0u ? mine : 1u; nx = cnt > 0u ? cnt : 1u;
}
__device__ __forceinline__ void xcd_barrier(const XcdBarrier& b) {
    asm volatile("s_waitcnt vmcnt(0)" ::: "memory");
    __syncthreads();
    if (opaque_tid() == 0) {
        unsigned* bar = b.bar;
        __builtin_amdgcn_s_waitcnt(0);
        unsigned nloc = b.st[0], nx = b.st[1];
        if (nloc == 0u) { xcd_barrier_complete(bar, b.x, nloc, nx); b.st[0] = nloc; b.st[1] = nx; }
        const unsigned old = xb_add(&bar[XB_XSUB(b.x)], 1u);
        const unsigned gen = old / nloc;
        if (old + 1u == (gen + 1u) * nloc) {
            __builtin_amdgcn_fence(__ATOMIC_RELEASE, "agent");
            asm volatile("s_waitcnt vmcnt(0)" ::: "memory");
            const unsigned og = xb_add(&bar[XB_TOP], 1u);
            const unsigned tg = og / nx;
            if (og + 1u == (tg + 1u) * nx) xb_add(&bar[XB_TOPGEN], 1u);
            else XB_SPIN(xb_ld(&bar[XB_TOPGEN]) == tg, bar);
            __builtin_amdgcn_fence(__ATOMIC_ACQUIRE, "agent");
            xb_add(&bar[XB_XGEN(b.x)], 1u);
            asm volatile("s_waitcnt vmcnt(0)" ::: "memory");
        } else {
            XB_SPIN(xb_ld(&bar[XB_XGEN(b.x)]) == gen, bar);
            __builtin_amdgcn_fence(__ATOMIC_ACQUIRE, "agent");
            asm volatile("s_waitcnt vmcnt(0)" ::: "memory");
        }
    }
    __syncthreads();
}

__global__ void __launch_bounds__(512) hybrid_fwd(Params p) {
    extern __shared__ __attribute__((aligned(16))) unsigned char lds_raw[];
    LAS unsigned char* lds = (LAS unsigned char*)lds_raw;
    cg::grid_group grid = cg::this_grid();
    const int G = gridDim.x, bx = blockIdx.x;
    const int vcu = (G % 8 == 0) ? (bx % 8) * (G / 8) + bx / 8 : bx;
    unsigned char* ws = p.ws;
    volatile LAS unsigned* misc = (volatile LAS unsigned*)(lds + MISC_OFF);
    if (threadIdx.x < 3) misc[threadIdx.x] = 0u;
    __syncthreads();
    if ((threadIdx.x & 63) == 0) {
        const unsigned hw = (unsigned)__builtin_amdgcn_s_getreg((5 << 11) | 4) & 63u;
        misc[4 + hw] = threadIdx.x >> 6;
    }
    __syncthreads();
    const XcdBarrier xbar = xcd_barrier_post((unsigned*)ws, misc);
    for (int ph = p.ph_lo; ph < p.ph_hi; ++ph) {
        if (ph == 0) prologue_phase(p, lds, vcu, G);
        else {
            const int l = (ph - 1) / 15, k = (ph - 1) % 15 + 1;
            unsigned char* wl = ws + WS_W + (size_t)l * WS_WL;
            int njobs = 0;
            if (k == 1) njobs = (l == 0) ? 5 : 1; else if (k == 3) njobs = (l == 0) ? 20 : 4; else if (k == 4) njobs = 2;
            else if (k == 6 || k == 9 || k == 11 || k == 13 || k == 14) njobs = 1;
#ifndef PROBE_MASK
#define PROBE_MASK 0
#endif
            const int nrep = ((PROBE_MASK >> k) & 1) ? 2 : 1;
            for (int rep = 0; rep < nrep; ++rep) {
            for (int job = 0; job < njobs; ++job) {
                pg8::Gemm g; pg8::Epi E; int M = MTOK, N = DM, c0 = 0;
                g.a_pn = 0; g.b_batch = 0; g.mtpb = 1 << 30; g.lda = DM; g.ldb = DM; g.K = DM;
                E.bias = nullptr; E.act = 0; E.sc_lo = 0; E.sc_hi = 0; E.sc = 1.f; E.ldc = DM; E.o_pn = 256; bool o_pm_set = false;
                E.xres = (const bf16_t*)(ws + WS_XRES); E.xres_out = (bf16_t*)(ws + WS_XRES); E.xout_f32 = nullptr; E.gpost = nullptr; E.rstd_out = (float*)(ws + WS_RSTD); E.rscale = nullptr; E.xb1 = (float*)(ws + WS_XB1); E.xb2 = (float*)(ws + WS_XB2); E.cnt1 = (unsigned*)(ws + CTL_CNT1); E.cnt2 = (unsigned*)(ws + CTL_CNT2); E.want = 0u;
                if (k == 1 && job == 0) { E.rscale = (const float*)(ws + WS_XB2); g.A = (const bf16_t*)(ws + WS_XRES); g.Bt = (const bf16_t*)(wl + W_IN); N = DINP; E.O = (bf16_t*)(ws + WS_PROJ); E.ldc = DINP; E.sc_lo = 3; E.sc_hi = 5; E.sc = 0.125f * LOG2E; }
                else if (k == 1) { const int ll = (job - 1) >> 1; unsigned char* w2 = ws + WS_W + (size_t)ll * WS_WL;
                    if ((job - 1) & 1) { g.A = (const bf16_t*)(w2 + W_MEMN); g.Bt = (const bf16_t*)(w2 + W_V); M = NB * NMEM; N = DM; E.O = (bf16_t*)(ws + WS_VMT + (size_t)ll * 4 * MiB); }
                    else { g.A = (const bf16_t*)(w2 + W_MEMN); g.Bt = (const bf16_t*)(w2 + W_K); M = NB * NMEM; N = DM; E.O = (bf16_t*)(ws + WS_KM + (size_t)ll * 4 * MiB); }
                    c0 = 32 * (job - 1); }
                else if (k == 3 && job < 2) { g.A = (const bf16_t*)(ws + (job ? WS_VCRAW : WS_KCRAW)); g.lda = 1024; g.K = 2048; g.Bt = (const bf16_t*)(wl + (job ? W_CV1 : W_CK1)); g.ldb = 2048;
                    M = 8192; N = 256; E.O = (bf16_t*)(ws + (job ? WS_HIDV : WS_HIDK)); E.ldc = 256; E.act = 2; E.bias = (const float*)(wl + (job ? W_CB1V : W_CB1K)); c0 = job * 32; }
                else if (k == 3 && job >= 4) { const int q = job - 4, ll = q >> 3, h = q & 3, kind = (q >> 2) & 1; unsigned char* w2 = ws + WS_W + (size_t)ll * WS_WL;
                    g.K = 256; c0 = 32 * (q & 7);
                    if (kind == 0) { g.A = (const bf16_t*)(ws + WS_KM + (size_t)ll * 4 * MiB) + h * 256; g.Bt = (const bf16_t*)(w2 + W_Q) + h * 256; M = NB * NMEM; N = DM;
                        E.O = (bf16_t*)(ws + WS_WQK + (size_t)ll * 16 * MiB) + (size_t)h * 256 * DM; E.o_pm = (unsigned)(DM * DM); o_pm_set = true; }
                    else { g.A = (const bf16_t*)(w2 + W_O) + h * 256; g.Bt = (const bf16_t*)(ws + WS_VMT + (size_t)ll * 4 * MiB) + h * 256; M = DM; N = NB * NMEM;
                        E.O = (bf16_t*)(ws + WS_VWO + (size_t)ll * 16 * MiB) + h * 256; E.o_pn = (unsigned)(DM * DM); } }
                else if (k == 3) { g.A = (const bf16_t*)(ws + WS_ACT) + (job == 3 ? 256 : 0); g.lda = 512; g.K = 256; g.Bt = (const bf16_t*)(wl + (job == 3 ? W_CPW : W_POOL)); g.ldb = 256;
                    N = 256; E.O = (bf16_t*)(ws + WS_CAT) + (job == 3 ? 256 : 0); c0 = 64; }
                else if (k == 4) { g.A = (const bf16_t*)(ws + (job ? WS_HIDV : WS_HIDK)); g.lda = 256; g.K = 256; g.Bt = (const bf16_t*)(wl + (job ? W_CV2 : W_CK2)); g.ldb = 256;
                    M = 8192; N = 256; E.O = (bf16_t*)(ws + (job ? WS_VC : WS_KC)); E.ldc = 256; c0 = job * 32; }
                else if (k == 6) { g.A = (const bf16_t*)(ws + WS_CAT); g.Bt = (const bf16_t*)(wl + W_OUT); E.act = 4;
                    E.gpost = p.in[I_MIXPOST] + l * DM; E.want = 32u * (unsigned)(3 * l + 1); }
                else if (k == 9) { g.A = (const bf16_t*)(ws + WS_XRES); g.Bt = (const bf16_t*)(ws + WS_WQK + (size_t)l * 16 * MiB); g.b_batch = (size_t)DM * DM; g.mtpb = 32;
                    E.rscale = (const float*)(ws + WS_XB2); E.sc_lo = 0; E.sc_hi = 4; E.sc = 0.0625f * LOG2E; E.O = (bf16_t*)(ws + WS_PROJ); E.act = 3; }
                else if (k == 11) { g.A = (const bf16_t*)(ws + WS_PROJ); g.Bt = (const bf16_t*)(ws + WS_VWO + (size_t)l * 16 * MiB); g.b_batch = (size_t)DM * DM; g.mtpb = 32; E.act = 4;
                    E.gpost = p.in[I_XAPOST] + l * DM; E.want = 32u * (unsigned)(3 * l + 2); }
                else if (k == 13) { E.rscale = (const float*)(ws + WS_XB2); g.A = (const bf16_t*)(ws + WS_XRES); g.Bt = (const bf16_t*)(wl + W_1); N = FF; E.O = (bf16_t*)(ws + WS_HID); E.ldc = FF; E.act = 1; }
                else { g.A = (const bf16_t*)(ws + WS_HID); g.lda = FF; g.K = FF; g.Bt = (const bf16_t*)(wl + W_2); g.ldb = FF; E.act = 4;
                    E.gpost = p.in[I_MLPPOST] + l * DM; if (l == 1) { E.xout_f32 = p.out; E.rstd_out = nullptr; } E.want = 32u * (unsigned)(3 * l + 3); }
                g.b_pn = (size_t)256 * g.ldb;
                if (!o_pm_set) E.o_pm = 256u * (unsigned)E.ldc;
                pg8::StaticOrder S; S.init(M, N, G, (bx - c0 + 4 * G) % G);
                if (E.act == 4) pg8::gemm_phase<1>(lds, g, S, E); else if (E.act == 3) pg8::gemm_phase<2>(lds, g, S, E); else pg8::gemm_phase<0>(lds, g, S, E);
            }
            if (k == 2) prep_phase(p, l, lds, vcu, G);
            else if (k == 3 && l == 0 && rep == 0) deferred_transposes(p, lds, bx, G);
            else if (k == 5) nsa::nsa_phase(p, l, lds, vcu, G);
            }
        }
        if (ph + 1 < p.ph_hi) { const int kk = ph == 0 ? 0 : (ph - 1) % 15 + 1; if (p.ph_hi > 64) grid.sync(); else if (!(kk == 7 || kk == 8 || kk == 10 || kk == 12 || kk == 15)) xcd_barrier(xbar); }
    }
}

extern "C" void kernel_launch(void* const* d_in, const int* in_sizes, int n_in, void* d_out, int out_size, void* d_ws, size_t ws_size, hipStream_t stream) {
    static int grid = 0;
    if (grid == 0) {
        if (n_in != 31 || ws_size < WS_END) { fprintf(stderr, "kernel_launch: unexpected inputs (n_in %d, ws %zu)\n", n_in, ws_size); grid = -1; return; }
        int dev = 0, cus = 0, per_cu = 0;
        hipGetDevice(&dev); hipDeviceGetAttribute(&cus, hipDeviceAttributeMultiprocessorCount, dev);
        hipFuncSetAttribute((const void*)hybrid_fwd, hipFuncAttributeMaxDynamicSharedMemorySize, LDS_BYTES);
        hipOccupancyMaxActiveBlocksPerMultiprocessor(&per_cu, (const void*)hybrid_fwd, 512, LDS_BYTES);
        (void)hipGetLastError();
        if (per_cu < 1) fprintf(stderr, "kernel_launch: occupancy query says %d blocks per CU\n", per_cu);
        grid = cus;
    }
    if (grid < 0) return;
    Params p{};
    for (int i = 0; i < 31; ++i) p.in[i] = (const float*)d_in[i];
    p.out = (float*)d_out; p.ws = (unsigned char*)d_ws; p.ph_lo = 0; p.ph_hi = 31;
    void* args[] = {&p};
    (void)hipMemsetAsync(d_ws, 0, CTL_ZERO, stream);
    hipError_t e = hipLaunchCooperativeKernel((const void*)hybrid_fwd, dim3(grid), dim3(512), args, LDS_BYTES, stream);
    if (e != hipSuccess) fprintf(stderr, "cooperative launch failed: %s (grid %d)\n", hipGetErrorString(e), grid);
}
```
